# Optimizing an MI355X kernel written in HIP

```python
import math
import jax, jax.numpy as jnp
from jax import lax
import numpy as np

D_MODEL = 2048
BATCH = 1
SEQ = 16384
DEPTH = 1

HEAD_DIM = 64
D_MIX = D_MODEL
SB_HEADS = 16
SW_HEADS = 16
SW_KV_HEADS = 4
SB_WIDTH = SB_HEADS * HEAD_DIM
SW_WIDTH = SW_HEADS * HEAD_DIM
SW_KV_WIDTH = SW_KV_HEADS * HEAD_DIM
WINDOW = 128
BLOCK = 128
N_BUCKETS = 32
MAX_DISTANCE = 128
RMS_EPS = 1e-6
SPLIT_POINTS = (
    SB_WIDTH,
    2 * SB_WIDTH,
    3 * SB_WIDTH,
    4 * SB_WIDTH,
    4 * SB_WIDTH + SW_WIDTH,
    4 * SB_WIDTH + SW_WIDTH + SW_KV_WIDTH,
    4 * SB_WIDTH + SW_WIDTH + 2 * SW_KV_WIDTH,
)
D_IN_PROJ = 4 * SB_WIDTH + 2 * SW_WIDTH + 2 * SW_KV_WIDTH

kernel_name = "hymba_stickbreak_swa_sandwich"


def rmsnorm(x, g):
    xf = x.astype(jnp.float32)
    y = xf * lax.rsqrt(jnp.mean(xf * xf, axis=-1, keepdims=True) + RMS_EPS)
    return (y * g.astype(jnp.float32)).astype(x.dtype)


def t5_bucket(dist):
    n = jnp.maximum(dist, 0)
    max_exact = N_BUCKETS // 2
    nf = jnp.maximum(n, 1).astype(jnp.float32)
    large = max_exact + (jnp.log(nf / max_exact) / math.log(MAX_DISTANCE / max_exact)
                         * (N_BUCKETS - max_exact)).astype(jnp.int32)
    large = jnp.minimum(large, N_BUCKETS - 1)
    return jnp.where(n < max_exact, n, large)


def stick_breaking_attention(q, k, v):
    b, s = q.shape[:2]
    nb = s // BLOCK
    scale = HEAD_DIM ** -0.5
    qh = q.reshape(b, nb, BLOCK, SB_HEADS, HEAD_DIM).transpose(1, 0, 2, 3, 4)
    kh = k.reshape(b, s, SB_HEADS, HEAD_DIM)
    vh = v.reshape(b, s, SB_HEADS, HEAD_DIM).astype(jnp.float32)
    key_pos = jnp.arange(s)

    def one_block(args):
        q_blk, blk = args
        z = jnp.einsum('bqhd,bshd->bhqs', q_blk, kh).astype(jnp.float32) * scale
        q_pos = blk * BLOCK + jnp.arange(BLOCK)
        before = key_pos[None, :] < q_pos[:, None]
        log_1m_beta = jnp.where(before, jax.nn.log_sigmoid(-z), 0.0)
        suffix = lax.cumsum(log_1m_beta, axis=3, reverse=True) - log_1m_beta
        w = jnp.where(before, jnp.exp(jax.nn.log_sigmoid(z) + suffix), 0.0)
        return jnp.einsum('bhqs,bshd->bqhd', w, vh)

    out = lax.map(one_block, (qh, jnp.arange(nb)))
    return out.transpose(1, 0, 2, 3, 4).reshape(b, s, SB_WIDTH).astype(q.dtype)


def sliding_window_gqa(q, k, v, sinks, rel_bias):
    b, s = q.shape[:2]
    nb = s // BLOCK
    grp = SW_HEADS // SW_KV_HEADS
    scale = HEAD_DIM ** -0.5
    qb = q.reshape(b, nb, BLOCK, SW_KV_HEADS, grp, HEAD_DIM)
    kh = k.reshape(b, s, SW_KV_HEADS, HEAD_DIM)
    vh = v.reshape(b, s, SW_KV_HEADS, HEAD_DIM)
    pad = ((0, 0), (BLOCK, 0), (0, 0), (0, 0))
    kp = jnp.pad(kh, pad)
    vp = jnp.pad(vh, pad)
    kb = jnp.concatenate([kp[:, :s].reshape(b, nb, BLOCK, SW_KV_HEADS, HEAD_DIM),
                          kh.reshape(b, nb, BLOCK, SW_KV_HEADS, HEAD_DIM)], axis=2)
    vb = jnp.concatenate([vp[:, :s].reshape(b, nb, BLOCK, SW_KV_HEADS, HEAD_DIM),
                          vh.reshape(b, nb, BLOCK, SW_KV_HEADS, HEAD_DIM)], axis=2)
    logits = jnp.einsum('bnqhgd,bnchd->bnhgqc', qb, kb).astype(jnp.float32) * scale

    qi = jnp.arange(BLOCK)[:, None]
    ci = jnp.arange(2 * BLOCK)[None, :]
    dist = qi + BLOCK - ci
    bias = rel_bias.astype(jnp.float32)[t5_bucket(dist)]
    bias = bias.transpose(2, 0, 1).reshape(SW_KV_HEADS, grp, BLOCK, 2 * BLOCK)
    in_window = (dist >= 0) & (dist < WINDOW)
    key_pos = jnp.arange(nb)[:, None] * BLOCK - BLOCK + ci
    valid = in_window[None] & (key_pos >= 0)[:, None, :]
    logits = jnp.where(valid[None, :, None, None], logits + bias, -jnp.inf)

    sink = sinks.astype(jnp.float32).reshape(SW_KV_HEADS, grp)[None, None, :, :, None, None]
    m = jnp.maximum(jnp.max(logits, axis=-1, keepdims=True), sink)
    p = jnp.exp(logits - m)
    denom = jnp.sum(p, axis=-1, keepdims=True) + jnp.exp(sink - m)
    out = jnp.einsum('bnhgqc,bnchd->bnqhgd', p / denom, vb.astype(jnp.float32))
    return out.reshape(b, s, SW_WIDTH).astype(q.dtype)


def setup_inputs(seed: int = 0) -> dict:
    key = jax.random.key(seed)
    ks = jax.random.split(key, 9)
    x = jax.random.normal(ks[0], (BATCH, SEQ, D_MODEL), jnp.float32)
    w_in = jax.random.normal(ks[1], (DEPTH, D_MODEL, D_IN_PROJ), jnp.float32) * D_MODEL ** -0.5
    w_out = jax.random.normal(ks[2], (DEPTH, D_MIX, D_MODEL), jnp.float32) * D_MIX ** -0.5
    norm_pre = 1.0 + 0.02 * jax.random.normal(ks[3], (DEPTH, D_MODEL), jnp.float32)
    norm_post = 1.0 + 0.02 * jax.random.normal(ks[4], (DEPTH, D_MODEL), jnp.float32)
    gn_sb = 1.0 + 0.02 * jax.random.normal(ks[5], (DEPTH, SB_WIDTH), jnp.float32)
    gn_sw = 1.0 + 0.02 * jax.random.normal(ks[6], (DEPTH, SW_WIDTH), jnp.float32)
    sinks = 0.5 * jax.random.normal(ks[7], (DEPTH, SW_HEADS), jnp.float32)
    rel_bias = 0.1 * jax.random.normal(ks[8], (N_BUCKETS, SW_HEADS), jnp.float32)
    return {"x": x, "w_in": w_in, "w_out": w_out, "norm_pre": norm_pre, "norm_post": norm_post,
            "gn_sb": gn_sb, "gn_sw": gn_sw, "sinks": sinks, "rel_bias": rel_bias}


def reference(x, w_in, w_out, norm_pre, norm_post, gn_sb, gn_sw, sinks, rel_bias):
    h = x
    for l in range(DEPTH):
        u = rmsnorm(h, norm_pre[l])
        proj = jnp.einsum('bsd,de->bse', u, w_in[l])
        q_sb, k_sb, v_sb, z_sb, q_sw, k_sw, v_sw, z_sw = jnp.split(proj, SPLIT_POINTS, axis=-1)
        o_sb = stick_breaking_attention(q_sb, k_sb, v_sb)
        o_sw = sliding_window_gqa(q_sw, k_sw, v_sw, sinks[l], rel_bias)
        o_sb = rmsnorm(o_sb, gn_sb[l]) * jax.nn.silu(z_sb)
        o_sw = rmsnorm(o_sw, gn_sw[l]) * jax.nn.silu(z_sw)
        y = jnp.einsum('bse,ed->bsd', jnp.concatenate([o_sb, o_sw], axis=-1), w_out[l])
        h = h + rmsnorm(y, norm_post[l])
    return h
```

```cpp
#include <hip/hip_runtime.h>
#include <cstdio>
#include <cstdint>

#ifndef MK_N_LAUNCHES
#define MK_N_LAUNCHES 1
#endif

namespace pg8 {
#define PG8_LAS __attribute__((address_space(3)))
typedef unsigned short bf16_t;
typedef short bf16x8 __attribute__((ext_vector_type(8)));
typedef float f32x4 __attribute__((ext_vector_type(4)));
typedef unsigned u32x4 __attribute__((ext_vector_type(4)));
constexpr int BM = 256, BK = 64, HALF = 128, HTB = HALF * BK * 2  , STAGE_BYTES = 8 * HTB, NXCD = 8, WGM = 8;

__host__ __device__ __forceinline__ int lds_byte(int r, int c) { const int st = (r >> 4) * 2 + (c >> 5), rr = r & 15, cc = c & 31, ob = rr * 64 + cc * 2; return st * 1024 + (ob ^ (((ob >> 9) & 1) << 5)); }
__host__ __device__ __forceinline__ void stage_rc(int b, int& R, int& C) { const int st = b / 1024, sb = b % 1024, swz = sb ^ (((sb >> 9) & 1) << 5); R = (st >> 1) * 16 + swz / 64; C = (st & 1) * 32 + (swz % 64) / 2; }
__host__ __device__ __forceinline__ int perm32(int rho) { const int n = rho >> 4, i = rho & 15; return 8 * (i >> 2) + 4 * n + (i & 3); }

struct Unit { int pm, pn; };
struct Gemm { const bf16_t* A; const bf16_t* Bt; int M, N, K; };

struct StaticOrder {
    int nM, nN, nwg, G, c;
    __host__ __device__ void init(int M, int N, int G_, int c_) { nM = M / BM; nN = N / BM; nwg = nM * nN; G = G_; c = c_; }
    __host__ __device__ bool next(int i, Unit& u) const {
        const long L = (long)i * G + c; if (L >= nwg) return false;
        int wgid = (int)L; { const int q = nwg / NXCD, r = nwg % NXCD, xcd = wgid % NXCD, off = wgid / NXCD; wgid = (xcd < r ? xcd * (q + 1) : r * (q + 1) + (xcd - r) * q) + off; }
        const int nig = WGM * nN, gid = wgid / nig, fm = gid * WGM, gsz = (nM - fm) < WGM ? (nM - fm) : WGM;
        u.pm = fm + ((wgid % nig) % gsz); u.pn = (wgid % nig) / gsz; return true;
    }
    __device__ __forceinline__ void a_ready(const Unit&) const {}
    __device__ __forceinline__ void done(const Unit&) const {}
};

__device__ __forceinline__ unsigned cvt_pk_bf16(float lo, float hi) { unsigned r; asm volatile("v_cvt_pk_bf16_f32 %0, %1, %2" : "=v"(r) : "v"(lo), "v"(hi)); return r; }

struct EpiProj {
    static constexpr bool PERM = true, AFTER_DRAIN = false, MID = false;
    bf16_t* O; int ldc; float qscale;
    __device__ __forceinline__ void mid(f32x4 (&)[2][2][4][2], int, int, int) const {}
    __device__ __forceinline__ void operator()(const f32x4 (&acc)[2][2][4][2], const Unit& u, int wr, int wc, int fr, int fq, int) const {
        const int row0 = u.pm * BM + wr * 64 + fr; const int colt = u.pn * BM;
        const float sc = (u.pn < 4 || (u.pn >= 16 && u.pn < 20)) ? qscale : 1.f;
        const int col0 = colt + wc * 32 + 8 * fq;
#pragma unroll
        for (int ai = 0; ai < 2; ++ai)
#pragma unroll
            for (int m = 0; m < 4; ++m) { bf16_t* rowp = O + (size_t)(row0 + ai * HALF + m * 16) * ldc + col0;
#pragma unroll
                for (int bj = 0; bj < 2; ++bj) { const f32x4 v0 = acc[ai][bj][m][0] * sc, v1 = acc[ai][bj][m][1] * sc;
                    u32x4 w; w.x = cvt_pk_bf16(v0[0], v0[1]); w.y = cvt_pk_bf16(v0[2], v0[3]); w.z = cvt_pk_bf16(v1[0], v1[1]); w.w = cvt_pk_bf16(v1[2], v1[3]);
                    *(u32x4*)(rowp + bj * HALF) = w; } }
    }
};
struct EpiY {
    static constexpr bool PERM = true, AFTER_DRAIN = false, MID = true;
    typedef float f32x2v __attribute__((ext_vector_type(2)));
    bf16_t* Y; int ldc; float* ssq; const PG8_LAS f32x2v* tab;
    __device__ __forceinline__ void mid(f32x4 (&acc)[2][2][4][2], int ui, int wr, int fr) const {
#pragma unroll
        for (int ai = 0; ai < 2; ++ai)
#pragma unroll
            for (int m = 0; m < 4; ++m) { const float r = tab[ui * BM + ai * HALF + wr * 64 + m * 16 + fr].x;
#pragma unroll
                for (int bj = 0; bj < 2; ++bj)
#pragma unroll
                    for (int n = 0; n < 2; ++n) acc[ai][bj][m][n] = acc[ai][bj][m][n] * r; }
    }
    __device__ __forceinline__ void operator()(const f32x4 (&acc)[2][2][4][2], const Unit& u, int wr, int wc, int fr, int fq, int ui) const {
        const int row0 = u.pm * BM + wr * 64 + fr; const int col0 = u.pn * BM + wc * 32 + 8 * fq;
#pragma unroll
        for (int ai = 0; ai < 2; ++ai)
#pragma unroll
            for (int m = 0; m < 4; ++m) { const int row = row0 + ai * HALF + m * 16; const float f = tab[ui * BM + ai * HALF + wr * 64 + m * 16 + fr].y;
                bf16_t* rowp = Y + (size_t)row * ldc + col0; float s = 0.f;
#pragma unroll
                for (int bj = 0; bj < 2; ++bj) { const f32x4 v0 = acc[ai][bj][m][0] * f, v1 = acc[ai][bj][m][1] * f;
                    s += (v0[0] * v0[0] + v0[1] * v0[1]) + (v0[2] * v0[2] + v0[3] * v0[3]) + (v1[0] * v1[0] + v1[1] * v1[1]) + (v1[2] * v1[2] + v1[3] * v1[3]);
                    u32x4 w; w.x = cvt_pk_bf16(v0[0], v0[1]); w.y = cvt_pk_bf16(v0[2], v0[3]); w.z = cvt_pk_bf16(v1[0], v1[1]); w.w = cvt_pk_bf16(v1[2], v1[3]);
                    *(u32x4*)(rowp + bj * HALF) = w; }
                s += __shfl_xor(s, 16); s += __shfl_xor(s, 32);
                if (fq == 0) ssq[(size_t)row * 32 + u.pn * 4 + wc] = s; }
    }
};

template <class Epi, class Sched, bool ALIGN_EPI = false, bool SP2 = false>
__device__ __forceinline__ void gemm_phase(PG8_LAS unsigned char* lds, const Gemm g, const Sched& S, const Epi& E) {
    const int tid = threadIdx.x, wid = __builtin_amdgcn_readfirstlane(tid >> 6), lane = tid & 63, wr = wid >> 2, wc = wid & 3, fr = lane & 15, fq = lane >> 4;
    const int K = g.K, nt = K / BK;
    unsigned voffA[2], voffB[2];
#pragma unroll
    for (int i = 0; i < 2; ++i) { int R, C; stage_rc(tid * 16 + i * 8192, R, C); const int Rb = Epi::PERM ? ((R & ~31) + perm32(R & 31)) : R;
        voffA[i] = (unsigned)(R * K + C) * 2u; voffB[i] = (unsigned)(Rb * K + C) * 2u; }
    const size_t kstep = (size_t)(BK * 2);
    const size_t hstep = (size_t)HALF * K * 2;
    const size_t tstep = 2 * hstep;
    const unsigned ldsw = (unsigned)wid * 1024u;
    const int aoff = lds_byte(wr * 64 + fr, fq * 8), boff = lds_byte(wc * 32 + fr, fq * 8);
#define PG8_SA(b, h) (((b) * 2 + (h)) * HTB)
#define PG8_SB(b, h) ((4 + (b) * 2 + (h)) * HTB)
#define PG8_STAGE(bufoff, gbase, voff) do { _Pragma("unroll") for (int _i = 0; _i < 2; ++_i) \
        __builtin_amdgcn_global_load_lds((const unsigned*)((const char*)(gbase) + (voff)[_i]), (PG8_LAS unsigned*)(lds + (bufoff) + ldsw + _i * 8192), 16, 0, 0); } while (0)
#define PG8_LDA(dst, b, h) do { _Pragma("unroll") for (int m = 0; m < 4; ++m) _Pragma("unroll") for (int k = 0; k < 2; ++k) dst[m][k] = *(const PG8_LAS bf16x8*)(lds + PG8_SA(b, h) + aoff + m * 2048 + k * 1024); } while (0)
#define PG8_LDB(dst, b, h) do { _Pragma("unroll") for (int n = 0; n < 2; ++n) _Pragma("unroll") for (int k = 0; k < 2; ++k) dst[n][k] = *(const PG8_LAS bf16x8*)(lds + PG8_SB(b, h) + boff + n * 2048 + k * 1024); } while (0)
#define PG8_MMA(ai, bj, At, Bt) do { __builtin_amdgcn_s_setprio(1); _Pragma("unroll") for (int m = 0; m < 4; ++m) _Pragma("unroll") for (int n = 0; n < 2; ++n) _Pragma("unroll") for (int k = 0; k < 2; ++k) \
        acc[ai][bj][m][n] = __builtin_amdgcn_mfma_f32_16x16x32_bf16(Bt[n][k], At[m][k], acc[ai][bj][m][n], 0, 0, 0); __builtin_amdgcn_s_setprio(0); } while (0)
#define PG8_WAIT_V(n) asm volatile("s_waitcnt vmcnt(" #n ")" ::: "memory")
#define PG8_WAIT_L(n) asm volatile("s_waitcnt lgkmcnt(" #n ")" ::: "memory")
#define PG8_BAR __builtin_amdgcn_s_barrier()
#define PG8_SCHED __builtin_amdgcn_sched_barrier(0)
    Unit cur, nxt; int ui = 0;
    if (!S.next(0, cur)) return;
    f32x4 acc[2][2][4][2];
#pragma unroll
    for (int a = 0; a < 2; ++a)
#pragma unroll
        for (int b = 0; b < 2; ++b)
#pragma unroll
            for (int m = 0; m < 4; ++m)
#pragma unroll
                for (int n = 0; n < 2; ++n) acc[a][b][m][n] = (f32x4){0.f, 0.f, 0.f, 0.f};
    bf16x8 At[4][2], B0[2][2], B1[2][2];
    const char* cA = (const char*)g.A + (size_t)cur.pm * tstep; const char* cB = (const char*)g.Bt + (size_t)cur.pn * tstep;
    S.a_ready(cur);
    if constexpr (SP2) {
        PG8_STAGE(PG8_SB(0, 0), cB, voffB); PG8_STAGE(PG8_SB(0, 1), cB + hstep, voffB); PG8_STAGE(PG8_SA(0, 0), cA, voffA); PG8_STAGE(PG8_SA(0, 1), cA + hstep, voffA);
        if (wr == 1) PG8_BAR;
        PG8_WAIT_V(2); PG8_BAR;
        PG8_STAGE(PG8_SB(1, 0), cB + kstep, voffB); PG8_STAGE(PG8_SA(1, 0), cA + kstep, voffA); PG8_STAGE(PG8_SB(1, 1), cB + hstep + kstep, voffB);
        PG8_WAIT_V(6); PG8_BAR;
    } else {
        PG8_STAGE(PG8_SB(0, 0), cB, voffB); PG8_STAGE(PG8_SA(0, 0), cA, voffA); PG8_STAGE(PG8_SB(0, 1), cB + hstep, voffB); PG8_STAGE(PG8_SA(0, 1), cA + hstep, voffA);
        if (wr == 1) PG8_BAR;
        PG8_WAIT_V(4); PG8_BAR;
        PG8_STAGE(PG8_SB(1, 0), cB + kstep, voffB); PG8_STAGE(PG8_SA(1, 0), cA + kstep, voffA); PG8_STAGE(PG8_SB(1, 1), cB + hstep + kstep, voffB);
        PG8_WAIT_V(6); PG8_BAR;
    }
    for (;;) {
        const bool has_next = S.next(ui + 1, nxt);
        const char* nA = has_next ? (const char*)g.A + (size_t)nxt.pm * tstep : cA; const char* nB = has_next ? (const char*)g.Bt + (size_t)nxt.pn * tstep : cB;
        for (int t = 0; t < nt; t += 2) {
            const bool last = (t == nt - 2);
            const char* a1 = cA + (size_t)(t + 1) * kstep;
            const char* a2 = last ? nA : cA + (size_t)(t + 2) * kstep; const char* b2 = last ? nB : cB + (size_t)(t + 2) * kstep;
            const char* a3 = a2 + kstep; const char* b3 = b2 + kstep;
            if (last && has_next) S.a_ready(nxt);
            if constexpr (Epi::MID) { if (t == nt / 2) { E.mid(acc, ui, wr, fr); PG8_SCHED; } }
            if constexpr (SP2) {
            PG8_LDB(B0, 0, 0); PG8_LDB(B1, 0, 1); PG8_SCHED; PG8_LDA(At, 0, 0); PG8_STAGE(PG8_SA(1, 1), a1 + hstep, voffA);
            PG8_WAIT_V(8); PG8_WAIT_L(0); PG8_BAR; PG8_MMA(0, 0, At, B0); PG8_MMA(0, 1, At, B1); PG8_BAR; PG8_SCHED;
            PG8_LDA(At, 0, 1); PG8_STAGE(PG8_SB(0, 0), b2, voffB); PG8_STAGE(PG8_SB(0, 1), b2 + hstep, voffB); PG8_STAGE(PG8_SA(0, 0), a2, voffA);
            PG8_WAIT_V(8); PG8_WAIT_L(0); PG8_BAR; PG8_MMA(1, 0, At, B0); PG8_MMA(1, 1, At, B1); PG8_BAR; PG8_SCHED;
            PG8_LDB(B0, 1, 0); PG8_LDB(B1, 1, 1); PG8_SCHED; PG8_LDA(At, 1, 0); PG8_STAGE(PG8_SA(0, 1), a2 + hstep, voffA);
            PG8_WAIT_V(8); PG8_WAIT_L(0); PG8_BAR; PG8_MMA(0, 0, At, B0); PG8_MMA(0, 1, At, B1); PG8_BAR; PG8_SCHED;
            PG8_LDA(At, 1, 1); PG8_STAGE(PG8_SB(1, 0), b3, voffB); PG8_STAGE(PG8_SB(1, 1), b3 + hstep, voffB); PG8_STAGE(PG8_SA(1, 0), a3, voffA);
            PG8_WAIT_V(8); PG8_WAIT_L(0); PG8_BAR; PG8_MMA(1, 0, At, B0); PG8_MMA(1, 1, At, B1); PG8_BAR; PG8_SCHED;
            } else {
            PG8_LDB(B0, 0, 0); PG8_SCHED; PG8_LDA(At, 0, 0); PG8_STAGE(PG8_SA(1, 1), a1 + hstep, voffA);
            PG8_WAIT_L(8); PG8_BAR; PG8_WAIT_L(0); PG8_MMA(0, 0, At, B0); PG8_BAR; PG8_SCHED;
            PG8_LDB(B1, 0, 1); PG8_STAGE(PG8_SB(0, 0), b2, voffB);
            PG8_BAR; PG8_WAIT_L(0); PG8_MMA(0, 1, At, B1); PG8_BAR;
            PG8_LDA(At, 0, 1); PG8_STAGE(PG8_SA(0, 0), a2, voffA);
            PG8_BAR; PG8_WAIT_L(0); PG8_MMA(1, 0, At, B0); PG8_BAR; PG8_SCHED;
            PG8_STAGE(PG8_SB(0, 1), b2 + hstep, voffB);
            PG8_WAIT_V(6); PG8_BAR; PG8_MMA(1, 1, At, B1); PG8_BAR;
            PG8_LDB(B0, 1, 0); PG8_SCHED; PG8_LDA(At, 1, 0); PG8_STAGE(PG8_SA(0, 1), a2 + hstep, voffA);
            PG8_WAIT_L(8); PG8_BAR; PG8_WAIT_L(0); PG8_MMA(0, 0, At, B0); PG8_BAR; PG8_SCHED;
            PG8_LDB(B1, 1, 1); PG8_STAGE(PG8_SB(1, 0), b3, voffB);
            PG8_BAR; PG8_WAIT_L(0); PG8_MMA(0, 1, At, B1); PG8_BAR;
            PG8_LDA(At, 1, 1); PG8_STAGE(PG8_SA(1, 0), a3, voffA);
            PG8_BAR; PG8_WAIT_L(0); PG8_MMA(1, 0, At, B0); PG8_BAR; PG8_SCHED;
            PG8_STAGE(PG8_SB(1, 1), b3 + hstep, voffB);
            PG8_WAIT_V(6); PG8_BAR; PG8_MMA(1, 1, At, B1); PG8_BAR;
            }
        }
        if constexpr (ALIGN_EPI) { if (wr == 0) PG8_BAR; }
        if constexpr (!Epi::AFTER_DRAIN) { E(acc, cur, wr, wc, fr, fq, ui); S.done(cur); }
        if (!has_next) break;
#pragma unroll
        for (int a = 0; a < 2; ++a)
#pragma unroll
            for (int b = 0; b < 2; ++b)
#pragma unroll
                for (int m = 0; m < 4; ++m)
#pragma unroll
                    for (int n = 0; n < 2; ++n) acc[a][b][m][n] = (f32x4){0.f, 0.f, 0.f, 0.f};
        cur = nxt; cA = nA; cB = nB; ++ui;
        if constexpr (ALIGN_EPI) { if (wr == 1) PG8_BAR; }
    }
    PG8_WAIT_V(0);
    if constexpr (!ALIGN_EPI) { if (wr == 0) PG8_BAR; }
    PG8_BAR;
#undef PG8_SA
#undef PG8_SB
#undef PG8_STAGE
#undef PG8_LDA
#undef PG8_LDB
#undef PG8_MMA
#undef PG8_WAIT_V
#undef PG8_WAIT_L
#undef PG8_BAR
#undef PG8_SCHED
}
}

constexpr int NWAVES = 8;
constexpr int N_LAUNCHES = MK_N_LAUNCHES;
constexpr int PER_PHASE = 5;
constexpr int M = 16384, DM = 2048, NP = 6656, HD = 64;
constexpr int C_QSB = 0, C_KSB = 1024, C_VSB = 2048, C_ZSB = 3072, C_QSW = 4096, C_KSW = 5120, C_VSW = 5376, C_ZSW = 5632;
constexpr float RMS_EPS = 1e-6f;
constexpr float LOG2E = 1.4426950408889634f;
constexpr float QSCALE = 0.125f * LOG2E;

constexpr size_t MiB = 1u << 20;
constexpr size_t WS_CTL = 0, CTL_ZERO_BYTES = 1 * MiB;
constexpr size_t WS_WIN = 2 * MiB;
constexpr size_t WS_WOUT = 28 * MiB;
constexpr size_t WS_SSQ1 = 36 * MiB;
constexpr size_t WS_SSQ2 = 38 * MiB;
constexpr size_t WS_XN = 40 * MiB;
constexpr size_t WS_A2 = 104 * MiB;
constexpr size_t WS_PROJ = 168 * MiB;
constexpr size_t WS_Y = 376 * MiB;
constexpr size_t WS_END = 440 * MiB;
constexpr int CW_TMO = 0, CW_CODE = 1;
constexpr int CW_BAR = 4096;

constexpr int RING_OFF = 0, RING_BYTES = 131072;
constexpr int LDSCTL_OFF = RING_BYTES, MISC_OFF = LDSCTL_OFF + 320;
constexpr int TAB_OFF = RING_BYTES + 1024;
constexpr int LDS_BYTES = 147456;
static_assert(TAB_OFF + 4096 <= LDS_BYTES && MISC_OFF + 128 <= TAB_OFF, "LDS map");

#define GAS __attribute__((address_space(1)))
#define LAS __attribute__((address_space(3)))
typedef unsigned short bf16;
typedef unsigned v4u __attribute__((ext_vector_type(4)));
typedef unsigned v2u __attribute__((ext_vector_type(2)));
typedef float f32x4 __attribute__((ext_vector_type(4)));
typedef float f32x2 __attribute__((ext_vector_type(2)));
typedef float f32x16 __attribute__((ext_vector_type(16)));
typedef short bf16x8 __attribute__((ext_vector_type(8)));
typedef short s16x4 __attribute__((ext_vector_type(4)));
typedef GAS unsigned gu32;
#define RLX_AGENT __ATOMIC_RELAXED, __HIP_MEMORY_SCOPE_AGENT
#define LDS_WAIT() asm volatile("s_waitcnt lgkmcnt(0)" ::: "memory")
#define VM_WAIT() asm volatile("s_waitcnt vmcnt(0)" ::: "memory")
__device__ __forceinline__ unsigned f2bf(float f) { unsigned u = __builtin_bit_cast(unsigned, f); return (u + 0x7fffu + ((u >> 16) & 1u)) >> 16; }
__device__ __forceinline__ unsigned pk2(float lo, float hi) { return f2bf(lo) | (f2bf(hi) << 16); }
__device__ __forceinline__ float bf_lo(unsigned w) { return __builtin_bit_cast(float, w << 16); }
__device__ __forceinline__ float bf_hi(unsigned w) { return __builtin_bit_cast(float, w & 0xffff0000u); }

#define XB_TMO      128
#define XB_XCNT(j)  (256  + 64 * (j))
#define XB_XSUB(j)  (1280 + 64 * (j))
#define XB_XGEN(j)  (2304 + 64 * (j))
#define XB_TOP      3328
#define XB_TOPGEN   3392
#define XCD_BAR_WORDS 3456
#define XB_SPIN_CAP (1u << 18)
__device__ __forceinline__ unsigned xb_ld(unsigned* p)              { return __hip_atomic_load(p, __ATOMIC_RELAXED, __HIP_MEMORY_SCOPE_AGENT); }
__device__ __forceinline__ unsigned xb_add(unsigned* p, unsigned v) { return __hip_atomic_fetch_add(p, v, __ATOMIC_RELAXED, __HIP_MEMORY_SCOPE_AGENT); }
__device__ __forceinline__ unsigned xb_xcc_id() { return (unsigned)__builtin_amdgcn_s_getreg((3 << 11) | 20) & 0xFu; }
#define XB_SPIN(cond, bar) do { unsigned _sp = 0; while (cond) { __builtin_amdgcn_s_sleep(1); \
    if ((++_sp & 255u) == 0u) { if (xb_ld(&(bar)[XB_TMO])) break; if (_sp > XB_SPIN_CAP) { atomicAdd(&(bar)[XB_TMO], 1u); break; } } } } while (0)
struct XcdBarrier { unsigned* bar; unsigned x; volatile LAS unsigned* st; };
__device__ __forceinline__ XcdBarrier xcd_barrier_post(unsigned* bar, volatile LAS unsigned* st) {
    XcdBarrier b; b.bar = bar; b.x = xb_xcc_id(); b.st = st;
    if (threadIdx.x == 0) (void)xb_add(&bar[XB_XCNT(b.x)], 1u);
    return b;
}
__device__ __forceinline__ void xcd_barrier_complete(unsigned* bar, unsigned x, unsigned& nloc, unsigned& nx) {
    const unsigned G = gridDim.x * gridDim.y * gridDim.z;
    unsigned sum, cnt, mine, sp = 0u;
    for (;;) {
        sum = 0u; cnt = 0u; mine = 0u;
#pragma unroll
        for (unsigned j = 0; j < 16; ++j) { const unsigned c = xb_ld(&bar[XB_XCNT(j)]); sum += c; cnt += (c > 0u) ? 1u : 0u; mine = (j == x) ? c : mine; }
        if (sum == G) break;
        __builtin_amdgcn_s_sleep(1);
        if ((++sp & 255u) == 0u) { if (xb_ld(&bar[XB_TMO])) break; if (sp > XB_SPIN_CAP) { atomicAdd(&bar[XB_TMO], 1u); break; } }
    }
    nloc = mine > 0u ? mine : 1u; nx = cnt > 0u ? cnt : 1u;
}
__device__ __forceinline__ void xcd_barrier(const XcdBarrier& b) {
    asm volatile("s_waitcnt vmcnt(0)" ::: "memory");
    __syncthreads();
    if (threadIdx.x == 0) {
        unsigned* bar = b.bar;
        __builtin_amdgcn_s_waitcnt(0);
        unsigned nloc = b.st[0], nx = b.st[1];
        if (nloc == 0u) { xcd_barrier_complete(bar, b.x, nloc, nx); b.st[0] = nloc; b.st[1] = nx; }
        const unsigned old = xb_add(&bar[XB_XSUB(b.x)], 1u);
        const unsigned gen = old / nloc;
        if (old + 1u == (gen + 1u) * nloc) {
            __builtin_amdgcn_fence(__ATOMIC_RELEASE, "agent");
            asm volatile("s_waitcnt vmcnt(0)" ::: "memory");
            const unsigned og = xb_add(&bar[XB_TOP], 1u);
            const unsigned tg = og / nx;
            if (og + 1u == (tg + 1u) * nx) xb_add(&bar[XB_TOPGEN], 1u);
            else XB_SPIN(xb_ld(&bar[XB_TOPGEN]) == tg, bar);
            __builtin_amdgcn_fence(__ATOMIC_ACQUIRE, "agent");
            xb_add(&bar[XB_XGEN(b.x)], 1u);
            asm volatile("s_waitcnt vmcnt(0)" ::: "memory");
        } else {
            XB_SPIN(xb_ld(&bar[XB_XGEN(b.x)]) == gen, bar);
            __builtin_amdgcn_fence(__ATOMIC_ACQUIRE, "agent");
            asm volatile("s_waitcnt vmcnt(0)" ::: "memory");
        }
    }
    __syncthreads();
}

struct Frame {
    LAS unsigned char* lds;
    volatile LAS unsigned* MISC;
    gu32* ctl;
    int tid, lane, wave;
    int vcu, G;
    const float *x, *w_in, *w_out, *g_pre, *g_post, *gn_sb, *gn_sw, *sinks, *rel_bias; float* out;
    bf16 *WinT, *WoutT, *XN, *A2, *PROJ, *Y; float *SSQ1, *SSQ2;
};

__device__ __forceinline__ float wave_sum(float v) {
#pragma unroll
    for (int o = 1; o < 64; o <<= 1) v += __shfl_xor(v, o);
    return v;
}
__device__ __forceinline__ void p0_transpose_item(const float* W, int K, int N, bf16* WT, LAS float* scr, int item, int lane) {
    const int nblk = N / 32, kb = item / nblk, nb = item % nblk, k0 = 64 * kb, n0 = 32 * nb;
#pragma unroll 8
    for (int i = 0; i < 32; ++i) { const int kk = 2 * i + (lane >> 5); scr[kk * 33 + (lane & 31)] = W[(size_t)(k0 + kk) * N + n0 + (lane & 31)]; }
    LDS_WAIT(); asm volatile("" ::: "memory");
    const int c = lane & 7;
#pragma unroll
    for (int j = 0; j < 4; ++j) { const int n = (lane >> 3) + 8 * j; const LAS float* s = scr + (8 * c) * 33 + n;
        v4u o; o.x = pk2(s[0 * 33], s[1 * 33]); o.y = pk2(s[2 * 33], s[3 * 33]); o.z = pk2(s[4 * 33], s[5 * 33]); o.w = pk2(s[6 * 33], s[7 * 33]);
        *(GAS v4u*)(WT + (size_t)(n0 + n) * K + k0 + 8 * c) = o; }
    LDS_WAIT(); asm volatile("" ::: "memory");
}
__device__ __forceinline__ void rms_row_to_bf16(int lane, const float* xrow, const float* g, bf16* orow) {
    const GAS f32x4* xr = (const GAS f32x4*)xrow + lane; const GAS f32x4* gr = (const GAS f32x4*)g + lane;
    f32x4 v[8]; float s = 0.f;
#pragma unroll
    for (int j = 0; j < 8; ++j) { v[j] = xr[64 * j]; s += (v[j].x * v[j].x + v[j].y * v[j].y) + (v[j].z * v[j].z + v[j].w * v[j].w); }
    const float rstd = 1.f / sqrtf(wave_sum(s) * (1.f / DM) + RMS_EPS);
    GAS v2u* o8 = (GAS v2u*)orow + lane;
#pragma unroll
    for (int j = 0; j < 8; ++j) { const f32x4 gg = gr[64 * j]; v2u o; o.x = pk2(v[j].x * rstd * gg.x, v[j].y * rstd * gg.y); o.y = pk2(v[j].z * rstd * gg.z, v[j].w * rstd * gg.w); o8[64 * j] = o; }
}
__device__ __forceinline__ void p0_prologue(Frame& F) {
    LAS float* scr = (LAS float*)(F.lds + RING_OFF + F.wave * 16384);
    const int gw = F.vcu * NWAVES + F.wave, NGW = F.G * NWAVES;
    constexpr int I_IN = (DM / 64) * (NP / 32), I_OUT = (DM / 64) * (DM / 32);
    for (int it = gw; it < I_IN + I_OUT; it += NGW) {
        if (it < I_IN) p0_transpose_item(F.w_in, DM, NP, F.WinT, scr, it, F.lane);
        else p0_transpose_item(F.w_out, DM, DM, F.WoutT, scr, it - I_IN, F.lane);
    }
    for (int m = gw; m < M; m += NGW) rms_row_to_bf16(F.lane, F.x + (size_t)m * DM, F.g_pre, F.XN + (size_t)m * DM);
}
__device__ __forceinline__ void p4_final(Frame& F) {
    const int gw = F.vcu * NWAVES + F.wave, NGW = F.G * NWAVES;
    for (int m = gw; m < M; m += NGW) {
        float s = (F.lane < 32) ? *(const GAS float*)(F.SSQ2 + (size_t)m * 32 + F.lane) : 0.f;
        const float rs = 1.f / sqrtf(wave_sum(s) * (1.f / DM) + RMS_EPS);
        const GAS f32x4* xr = (const GAS f32x4*)(F.x + (size_t)m * DM) + F.lane; const GAS f32x4* gr = (const GAS f32x4*)F.g_post + F.lane;
        const GAS v2u* yr = (const GAS v2u*)(F.Y + (size_t)m * DM) + F.lane; GAS f32x4* orow = (GAS f32x4*)(F.out + (size_t)m * DM) + F.lane;
#pragma unroll
        for (int j = 0; j < 8; ++j) { const f32x4 xv = xr[64 * j], gg = gr[64 * j]; const v2u yv = yr[64 * j];
            f32x4 o; o.x = xv.x + bf_lo(yv.x) * rs * gg.x; o.y = xv.y + bf_hi(yv.x) * rs * gg.y; o.z = xv.z + bf_lo(yv.y) * rs * gg.z; o.w = xv.w + bf_hi(yv.y) * rs * gg.w;
            orow[64 * j] = o; }
    }
}

namespace att {
constexpr int NSLOT = 12, KB = 4096;
constexpr int L_K = 0, L_V = NSLOT * KB, L_TBL = 2 * NSLOT * KB, L_FLG = L_TBL + 1024, L_END = L_FLG + 64;
constexpr int STG_PITCH = 272, STG_WAVE = 32 * STG_PITCH;
static_assert(L_END <= RING_BYTES && 8 * STG_WAVE <= L_TBL, "attention LDS map");
__device__ __forceinline__ int crow(int r, int hi) { return (r & 3) + 8 * (r >> 2) + 4 * hi; }
__device__ __forceinline__ float swap_lo(float v, float& hi_out) {
    auto rr = __builtin_amdgcn_permlane32_swap(__float_as_uint(v), __float_as_uint(v), false, false);
    hi_out = __uint_as_float(rr[1]); return __uint_as_float(rr[0]);
}
typedef short v4i16_t __attribute__((ext_vector_type(4)));
__device__ __forceinline__ s16x4 vtr(const LAS unsigned char* p) { return __builtin_bit_cast(s16x4, __builtin_amdgcn_ds_read_tr16_b64_v4i16((LAS v4i16_t*)p)); }

template <bool SB>
__device__ __forceinline__ void unit(Frame& F, int head, int qt) {
    const int tid = F.tid, lane = F.lane, wid = F.wave, r32 = lane & 31, hh = lane >> 5;
    LAS unsigned char* ring = F.lds + RING_OFF;
    volatile LAS unsigned* flg = (volatile LAS unsigned*)(ring + L_FLG);
    LAS float* tbl = (LAS float*)(ring + L_TBL);
    const int T0 = qt * 8, q0w = qt * 256 + wid * 32;
    const int qcol = SB ? C_QSB + head * HD : C_QSW + head * HD;
    const int kcol = SB ? C_KSB + head * HD : C_KSW + (head >> 2) * HD;
    const int vcol = SB ? C_VSB + head * HD : C_VSW + (head >> 2) * HD;
    const int zcol = SB ? C_ZSB + head * HD : C_ZSW + head * HD;
    const int lrow = (tid >> 3) & 31, lch = tid & 7;
    const bf16* lsrc = F.PROJ + (size_t)lrow * NP + (tid < 256 ? kcol : vcol) + lch * 8;
    const int ldst = (tid < 256 ? L_K : L_V) + lrow * 128 + lch * 16;
    if (tid < 16) flg[tid] = 0u;
    if (!SB) {
        if (tid < 192) { const int dist = 159 - tid; float v = -INFINITY;
            if (dist >= 0 && dist < 128) { int b = dist; if (dist >= 16) { b = 16 + (int)(logf((float)dist * (1.f / 16.f)) / 2.0794415416798357f * 16.f); b = b > 31 ? 31 : b; }
                v = F.rel_bias[b * 16 + head] * LOG2E; }
            tbl[tid] = v; }
    }
    {
        v4u pre[8];
#pragma unroll
        for (int i = 0; i < 8; ++i) pre[i] = *(const GAS v4u*)(lsrc + (size_t)(T0 + i) * 32 * NP);
#pragma unroll
        for (int i = 0; i < 8; ++i) *(LAS v4u*)(ring + ldst + ((T0 + i) % NSLOT) * KB) = pre[i];
    }
    bf16x8 qr[4];
    { const bf16* qp = F.PROJ + (size_t)(q0w + r32) * NP + qcol + hh * 8;
#pragma unroll
      for (int d0 = 0; d0 < 4; ++d0) qr[d0] = *(const GAS bf16x8*)(qp + d0 * 16); }
    f32x16 o0 = {}, o1 = {};
    float carry = 1.f;
    float mrun = SB ? 0.f : F.sinks[head] * LOG2E, lrun = 1.f;
    bool done = false;
    __syncthreads();
    const int kbase = r32 * 128 + hh * 16;
    const int vbase = (4 * hh + ((lane & 15) >> 2)) * 128 + (16 * ((lane >> 4) & 1) + 4 * (lane & 3)) * 2;
    for (int j = 0;; ++j) {
        const int kt = T0 + wid - j;
        const bool act = (kt >= 0) && !done;
        const int xt = T0 - j - 1; const bool pf = xt >= 0;
        v4u pre1 = {};
        if (pf) pre1 = *(const GAS v4u*)(lsrc + (size_t)xt * 32 * NP);
        if (act) {
            const int slot = kt % NSLOT;
            const LAS unsigned char* kp = ring + L_K + slot * KB + kbase;
            const LAS unsigned char* vp = ring + L_V + slot * KB + vbase;
            f32x16 p;
            if (SB) p = (f32x16){};
            else { const LAS float* tb = tbl + (159 - 32 * j - r32 + 4 * hh);
#pragma unroll
                for (int r = 0; r < 16; ++r) p[r] = tb[crow(r, 0)]; }
#pragma unroll
            for (int d0 = 0; d0 < 4; ++d0) { const bf16x8 kf = *(const LAS bf16x8*)(kp + d0 * 32); p = __builtin_amdgcn_mfma_f32_32x32x16_bf16(kf, qr[d0], p, 0, 0, 0); }
            float w[16];
            if (SB) {
                float s[16];
#pragma unroll
                for (int r = 0; r < 16; ++r) { const float zc = fminf(p[r], 100.f); float e = __builtin_amdgcn_exp2f(zc); float u = __builtin_amdgcn_rcpf(1.f + e);
                    if (j == 0) { const bool msk = crow(r, hh) >= r32; e = msk ? 0.f : e; u = msk ? 1.f : u; }
                    w[r] = e; s[r] = u; }
                float r1[4], P[4];
#pragma unroll
                for (int g = 0; g < 4; ++g) { s[4 * g + 2] *= s[4 * g + 3]; s[4 * g + 1] *= s[4 * g + 2]; s[4 * g] *= s[4 * g + 1]; const float r0 = swap_lo(s[4 * g], r1[g]); P[g] = r0 * r1[g]; }
                float A[4]; A[3] = carry; A[2] = A[3] * P[3]; A[1] = A[2] * P[2]; A[0] = A[1] * P[1]; carry = A[0] * P[0];
#pragma unroll
                for (int g = 0; g < 4; ++g) { const float off = hh == 0 ? A[g] * r1[g] : A[g];
#pragma unroll
                    for (int i = 0; i < 4; ++i) w[4 * g + i] = w[4 * g + i] * (s[4 * g + i] * off); }
            } else {
                float rm = p[0];
#pragma unroll
                for (int r = 1; r < 16; ++r) rm = fmaxf(rm, p[r]);
                { float hi; const float lo = swap_lo(rm, hi); rm = fmaxf(lo, hi); }
                const float mn = fmaxf(mrun, rm), alpha = __builtin_amdgcn_exp2f(mrun - mn); mrun = mn;
                float sum = 0.f;
#pragma unroll
                for (int r = 0; r < 16; ++r) { w[r] = __builtin_amdgcn_exp2f(p[r] - mn); sum += w[r]; }
                { float hi; const float lo = swap_lo(sum, hi); sum = lo + hi; }
                lrun = lrun * alpha + sum;
#pragma unroll
                for (int r = 0; r < 16; ++r) { o0[r] *= alpha; o1[r] *= alpha; }
            }
#pragma unroll
            for (int s2 = 0; s2 < 2; ++s2) {
                v4u wp; wp.x = pg8::cvt_pk_bf16(w[8 * s2 + 0], w[8 * s2 + 1]); wp.y = pg8::cvt_pk_bf16(w[8 * s2 + 2], w[8 * s2 + 3]); wp.z = pg8::cvt_pk_bf16(w[8 * s2 + 4], w[8 * s2 + 5]); wp.w = pg8::cvt_pk_bf16(w[8 * s2 + 6], w[8 * s2 + 7]);
                const bf16x8 wf = __builtin_bit_cast(bf16x8, wp);
#pragma unroll
                for (int db = 0; db < 2; ++db) {
                    const s16x4 lo = vtr(vp + (16 * s2) * 128 + db * 64), hi = vtr(vp + (16 * s2 + 8) * 128 + db * 64);
                    const bf16x8 vf = (bf16x8){lo[0], lo[1], lo[2], lo[3], hi[0], hi[1], hi[2], hi[3]};
                    if (db == 0) o0 = __builtin_amdgcn_mfma_f32_32x32x16_bf16(vf, wf, o0, 0, 0, 0); else o1 = __builtin_amdgcn_mfma_f32_32x32x16_bf16(vf, wf, o1, 0, 0, 0);
                }
            }
        }
        if (SB) done = done || (kt <= 0) || __all(carry == 0.f);
        else done = done || (kt <= 0) || (j >= 4);
        if (pf) *(LAS v4u*)(ring + ldst + (xt % NSLOT) * KB) = pre1;
        if (lane == 0) flg[(j & 1) * 8 + wid] = done ? 1u : 0u;
        __syncthreads();
        unsigned alld = 1u;
#pragma unroll
        for (int i = 0; i < 8; ++i) alld &= flg[(j & 1) * 8 + i];
        if (alld) break;
    }
    if (!SB) { const float il = 1.f / lrun;
#pragma unroll
        for (int r = 0; r < 16; ++r) { o0[r] *= il; o1[r] *= il; } }
    { float ss = 0.f;
#pragma unroll
      for (int r = 0; r < 16; ++r) ss += o0[r] * o0[r] + o1[r] * o1[r];
      float hi; const float lo = swap_lo(ss, hi); ss = lo + hi;
      if (hh == 0) F.SSQ1[(size_t)(q0w + r32) * 32 + (SB ? 0 : 16) + head] = ss; }
    LAS unsigned char* stg = ring + wid * STG_WAVE;
#pragma unroll
    for (int g = 0; g < 4; ++g) {
        *(LAS f32x4*)(stg + r32 * STG_PITCH + (8 * g + 4 * hh) * 4) = (f32x4){o0[4 * g], o0[4 * g + 1], o0[4 * g + 2], o0[4 * g + 3]};
        *(LAS f32x4*)(stg + r32 * STG_PITCH + (32 + 8 * g + 4 * hh) * 4) = (f32x4){o1[4 * g], o1[4 * g + 1], o1[4 * g + 2], o1[4 * g + 3]};
    }
    LDS_WAIT(); asm volatile("" ::: "memory");
    const float* gn = SB ? F.gn_sb : F.gn_sw;
#pragma unroll
    for (int k = 0; k < 4; ++k) {
        const int piece = lane + 64 * k, row = piece >> 3, ch = piece & 7;
        const f32x4 a = *(const LAS f32x4*)(stg + row * STG_PITCH + ch * 32), b = *(const LAS f32x4*)(stg + row * STG_PITCH + ch * 32 + 16);
        const v4u zz = *(const GAS v4u*)(F.PROJ + (size_t)(q0w + row) * NP + zcol + ch * 8);
        const f32x4 g0 = *(const GAS f32x4*)(gn + head * HD + ch * 8), g1 = *(const GAS f32x4*)(gn + head * HD + ch * 8 + 4);
        float z[8] = {bf_lo(zz.x), bf_hi(zz.x), bf_lo(zz.y), bf_hi(zz.y), bf_lo(zz.z), bf_hi(zz.z), bf_lo(zz.w), bf_hi(zz.w)};
        float ov[8] = {a.x * g0.x, a.y * g0.y, a.z * g0.z, a.w * g0.w, b.x * g1.x, b.y * g1.y, b.z * g1.z, b.w * g1.w};
#pragma unroll
        for (int i = 0; i < 8; ++i) ov[i] *= z[i] * __builtin_amdgcn_rcpf(1.f + __builtin_amdgcn_exp2f(-z[i] * LOG2E));
        v4u ow; ow.x = pg8::cvt_pk_bf16(ov[0], ov[1]); ow.y = pg8::cvt_pk_bf16(ov[2], ov[3]); ow.z = pg8::cvt_pk_bf16(ov[4], ov[5]); ow.w = pg8::cvt_pk_bf16(ov[6], ov[7]);
        *(GAS v4u*)(F.A2 + (size_t)(q0w + row) * DM + (SB ? 0 : 1024) + head * HD + ch * 8) = ow;
    }
    __syncthreads();
}

__device__ __forceinline__ void phase(Frame& F) {
    for (int u = F.vcu; u < 2048; u += F.G) {
        if (u < 1024) unit<true>(F, u >> 6, u & 63);
        else unit<false>(F, (u - 1024) >> 6, u & 63);
    }
}
}

struct Args { const float* in[9]; float* out; unsigned char* ws; int ph_lo, ph_hi, li, pad; };
__global__ void __launch_bounds__(NWAVES * 64, 2) hymba_fwd(Args args) {
    extern __shared__ __attribute__((aligned(16))) unsigned char lds[];
    Frame F;
    F.lds = (LAS unsigned char*)lds;
    F.MISC = (volatile LAS unsigned*)(F.lds + MISC_OFF);
    F.tid = threadIdx.x; F.lane = F.tid & 63; F.wave = __builtin_amdgcn_readfirstlane(F.tid >> 6);
    F.G = gridDim.x; { const int bx = blockIdx.x; F.vcu = (F.G % 8 == 0) ? (bx % 8) * (F.G / 8) + bx / 8 : bx; }
    unsigned char* ws = args.ws;
    F.ctl = (gu32*)(ws + WS_CTL);
    F.x = args.in[0]; F.w_in = args.in[1]; F.w_out = args.in[2]; F.g_pre = args.in[3]; F.g_post = args.in[4]; F.gn_sb = args.in[5]; F.gn_sw = args.in[6]; F.sinks = args.in[7]; F.rel_bias = args.in[8];
    F.out = args.out;
    F.WinT = (bf16*)(ws + WS_WIN); F.WoutT = (bf16*)(ws + WS_WOUT); F.XN = (bf16*)(ws + WS_XN); F.A2 = (bf16*)(ws + WS_A2); F.PROJ = (bf16*)(ws + WS_PROJ); F.Y = (bf16*)(ws + WS_Y);
    F.SSQ1 = (float*)(ws + WS_SSQ1); F.SSQ2 = (float*)(ws + WS_SSQ2);
    for (int u = F.tid; u < (TAB_OFF - LDSCTL_OFF) / 4; u += NWAVES * 64) ((LAS unsigned*)(F.lds + LDSCTL_OFF))[u] = 0u;
    __syncthreads();
    XcdBarrier bar; bar.bar = (unsigned*)(F.ctl + CW_BAR); bar.x = 0; bar.st = nullptr;
    if (N_LAUNCHES != PER_PHASE) bar = xcd_barrier_post((unsigned*)(F.ctl + CW_BAR), F.MISC + 8);
#define GRID_BAR(seam) do { if (N_LAUNCHES == PER_PHASE) { if (F.tid == 0) __hip_atomic_store(F.ctl + CW_TMO, 0xBADBA0u | (unsigned)(seam), RLX_AGENT); } else { xcd_barrier(bar); } } while (0)
    const int lo = args.ph_lo, hi = args.ph_hi;
#define IN(k) (lo <= (k) && (k) < hi)
#define BOTH(k) (IN(k) && IN((k) + 1))

    if (IN(0)) { p0_prologue(F); if (BOTH(0)) GRID_BAR(0); }

    if (IN(1)) {
        pg8::Gemm g{F.XN, F.WinT, M, NP, DM}; pg8::StaticOrder S; S.init(M, NP, F.G, (int)blockIdx.x);
        pg8::EpiProj E{F.PROJ, NP, QSCALE};
        pg8::gemm_phase<pg8::EpiProj, pg8::StaticOrder, true, true>(F.lds + RING_OFF, g, S, E);
        if (BOTH(1)) GRID_BAR(1);
    }

    if (IN(2)) { att::phase(F); if (BOTH(2)) GRID_BAR(2); }

    if (IN(3)) {
        pg8::StaticOrder S; S.init(M, DM, F.G, (int)blockIdx.x);
        LAS f32x2* tab = (LAS f32x2*)(F.lds + TAB_OFF);
        { const int ui = F.tid >> 8, row = F.tid & 255; pg8::Unit u;
          if (S.next(ui, u)) { const GAS f32x4* sp = (const GAS f32x4*)(F.SSQ1 + (size_t)(u.pm * 256 + row) * 32);
              float a = 0.f, b = 0.f;
#pragma unroll
              for (int i = 0; i < 4; ++i) { const f32x4 v = sp[i], w = sp[4 + i]; a += (v.x + v.y) + (v.z + v.w); b += (w.x + w.y) + (w.z + w.w); }
              const float rsb = 1.f / sqrtf(a * (1.f / 1024.f) + RMS_EPS), rsw = 1.f / sqrtf(b * (1.f / 1024.f) + RMS_EPS);
              tab[ui * 256 + row] = (f32x2){rsb / rsw, rsw}; } }
        __syncthreads();
        pg8::Gemm g{F.A2, F.WoutT, M, DM, DM};
        pg8::EpiY E{F.Y, DM, F.SSQ2, (const LAS pg8::EpiY::f32x2v*)tab};
        pg8::gemm_phase<pg8::EpiY, pg8::StaticOrder, true, true>(F.lds + RING_OFF, g, S, E);
        if (BOTH(3)) GRID_BAR(3);
    }

    if (IN(4)) { p4_final(F); }
#undef IN
#undef BOTH
}

extern "C" void kernel_launch(void* const* d_in, const int* in_sizes, int n_in, void* d_out, int out_size, void* d_ws, size_t ws_size, hipStream_t stream) {
    static int grid = 0;
    if (grid == 0) {
        if (n_in != 9 || in_sizes[0] != M * DM || out_size != M * DM || ws_size < WS_END) { fprintf(stderr, "kernel_launch: unexpected shapes (n_in %d, in0 %d, out %d, ws %zu); nothing launched\n", n_in, n_in > 0 ? in_sizes[0] : -1, out_size, ws_size); grid = -1; return; }
        int dev = 0, cus = 0, per_cu = 0;
        if (hipGetDevice(&dev) != hipSuccess || hipDeviceGetAttribute(&cus, hipDeviceAttributeMultiprocessorCount, dev) != hipSuccess) { fprintf(stderr, "kernel_launch: device query failed\n"); grid = -1; return; }
        if (hipFuncSetAttribute((const void*)hymba_fwd, hipFuncAttributeMaxDynamicSharedMemorySize, LDS_BYTES) != hipSuccess) { fprintf(stderr, "kernel_launch: hipFuncSetAttribute failed\n"); grid = -1; return; }
        if (hipOccupancyMaxActiveBlocksPerMultiprocessor(&per_cu, (const void*)hymba_fwd, NWAVES * 64, LDS_BYTES) != hipSuccess || per_cu < 1) { fprintf(stderr, "kernel_launch: occupancy query reports %d workgroups per CU\n", per_cu); per_cu = 1; }
        (void)hipGetLastError();
        grid = cus;
    }
    if (grid < 0) return;
    if (hipMemsetAsync((char*)d_ws + WS_CTL, 0, CTL_ZERO_BYTES, stream) != hipSuccess) { fprintf(stderr, "kernel_launch: hipMemsetAsync failed\n"); return; }
    Args a{};
    for (int i = 0; i < 9; ++i) a.in[i] = (const float*)d_in[i];
    a.out = (float*)d_out; a.ws = (unsigned char*)d_ws;
    for (int li = 0; li < N_LAUNCHES; ++li) {
        a.ph_lo = (N_LAUNCHES == PER_PHASE) ? li : 0; a.ph_hi = (N_LAUNCHES == PER_PHASE) ? li + 1 : PER_PHASE; a.li = li;
        hipLaunchKernelGGL(hymba_fwd, dim3(grid), dim3(NWAVES * 64), LDS_BYTES, stream, a);
        const hipError_t le = hipPeekAtLastError();
        if (le != hipSuccess) { fprintf(stderr, "kernel_launch: launch %d failed: %s\n", li, hipGetErrorName(le)); break; }
    }
}
```

```cpp
#include <hip/hip_runtime.h>
#include <cstdio>
#include <cstdint>

#ifndef MK_ATT_EXTRA
#define MK_ATT_EXTRA 0
#endif
#ifndef MK_ATT_DUP
#define MK_ATT_DUP 1
#endif
#ifndef MK_ATT_DUPST
#define MK_ATT_DUPST 1
#endif
#ifndef MK_REPEAT
#define MK_REPEAT -1
#endif
#ifndef MK_N_LAUNCHES
#define MK_N_LAUNCHES 1
#endif

namespace pg8 {
#define PG8_LAS __attribute__((address_space(3)))
typedef unsigned short bf16_t;
typedef short bf16x8 __attribute__((ext_vector_type(8)));
typedef float f32x4 __attribute__((ext_vector_type(4)));
typedef unsigned u32x4 __attribute__((ext_vector_type(4)));
constexpr int BM = 256, BK = 64, HALF = 128, HTB = HALF * BK * 2  , STAGE_BYTES = 8 * HTB, NXCD = 8, WGM = 8;

__host__ __device__ __forceinline__ int lds_byte(int r, int c) { const int st = (r >> 4) * 2 + (c >> 5), rr = r & 15, cc = c & 31, ob = rr * 64 + cc * 2; return st * 1024 + (ob ^ (((ob >> 9) & 1) << 5)); }
__host__ __device__ __forceinline__ void stage_rc(int b, int& R, int& C) { const int st = b / 1024, sb = b % 1024, swz = sb ^ (((sb >> 9) & 1) << 5); R = (st >> 1) * 16 + swz / 64; C = (st & 1) * 32 + (swz % 64) / 2; }
__host__ __device__ __forceinline__ int perm32(int rho) { const int n = rho >> 4, i = rho & 15; return 8 * (i >> 2) + 4 * n + (i & 3); }

struct Unit { int pm, pn; };
struct Gemm { const bf16_t* A; const bf16_t* Bt; int M, N, K; };

struct StaticOrder {
    int nM, nN, nwg, G, c;
    __host__ __device__ void init(int M, int N, int G_, int c_) { nM = M / BM; nN = N / BM; nwg = nM * nN; G = G_; c = c_; }
    __host__ __device__ bool next(int i, Unit& u) const {
        const long L = (long)i * G + c; if (L >= nwg) return false;
        int wgid = (int)L; { const int q = nwg / NXCD, r = nwg % NXCD, xcd = wgid % NXCD, off = wgid / NXCD; wgid = (xcd < r ? xcd * (q + 1) : r * (q + 1) + (xcd - r) * q) + off; }
        const int nig = WGM * nN, gid = wgid / nig, fm = gid * WGM, gsz = (nM - fm) < WGM ? (nM - fm) : WGM;
        u.pm = fm + ((wgid % nig) % gsz); u.pn = (wgid % nig) / gsz; return true;
    }
    __device__ __forceinline__ void a_ready(const Unit&) const {}
    __device__ __forceinline__ void done(const Unit&) const {}
};

__device__ __forceinline__ unsigned cvt_pk_bf16(float lo, float hi) { unsigned r; asm volatile("v_cvt_pk_bf16_f32 %0, %1, %2" : "=v"(r) : "v"(lo), "v"(hi)); return r; }

struct EpiProj {
    static constexpr bool PERM = true, AFTER_DRAIN = false, MID = false, ABLK = false;
    bf16_t* KV; bf16_t* QB; bf16_t* ZB; float qscale;
    __device__ __forceinline__ void mid(f32x4 (&)[2][2][4][2], int, int, int) const {}
    __device__ __forceinline__ void operator()(const f32x4 (&acc)[2][2][4][2], const Unit& u, int wr, int wc, int fr, int fq, int) const {
        const int pn = u.pn, row0 = u.pm * BM + wr * 64 + fr;
        const bool isq = pn < 4 || (pn >= 16 && pn < 20), gate = (pn >= 12 && pn < 16) || pn >= 22;
        const float sc = isq ? qscale : 1.f;
        if (isq || gate) {
            bf16_t* base = isq ? QB : ZB;
            const int colt = (pn < 16 ? (pn & 3) * BM : 1024 + ((pn - (isq ? 16 : 22)) * BM)) + wc * 32 + 8 * fq;
#pragma unroll
            for (int ai = 0; ai < 2; ++ai)
#pragma unroll
                for (int m = 0; m < 4; ++m) { const int row = row0 + ai * HALF + m * 16;
#pragma unroll
                    for (int bj = 0; bj < 2; ++bj) { f32x4 v0 = acc[ai][bj][m][0] * sc, v1 = acc[ai][bj][m][1] * sc;
                        if (gate) {
#pragma unroll
                            for (int j = 0; j < 4; ++j) { v0[j] = v0[j] * __builtin_amdgcn_rcpf(1.f + __builtin_amdgcn_exp2f(v0[j] * -1.4426950408889634f)); v1[j] = v1[j] * __builtin_amdgcn_rcpf(1.f + __builtin_amdgcn_exp2f(v1[j] * -1.4426950408889634f)); } }
                        u32x4 w; w.x = cvt_pk_bf16(v0[0], v0[1]); w.y = cvt_pk_bf16(v0[2], v0[3]); w.z = cvt_pk_bf16(v1[0], v1[1]); w.w = cvt_pk_bf16(v1[2], v1[3]);
                        const int col = colt + bj * HALF;
                        *(u32x4*)(base + ((size_t)(row >> 5) * 256 + (col >> 3)) * 256 + (row & 31) * 8) = w; } }
        } else {
            const int colt = (pn < 12 ? (pn - 4) * BM : 2048 + (pn - 20) * BM) + wc * 32 + 8 * fq;
#pragma unroll
            for (int ai = 0; ai < 2; ++ai)
#pragma unroll
                for (int m = 0; m < 4; ++m) { bf16_t* rowp = KV + (size_t)(row0 + ai * HALF + m * 16) * 2560 + colt;
#pragma unroll
                    for (int bj = 0; bj < 2; ++bj) { const f32x4 v0 = acc[ai][bj][m][0], v1 = acc[ai][bj][m][1];
                        u32x4 w; w.x = cvt_pk_bf16(v0[0], v0[1]); w.y = cvt_pk_bf16(v0[2], v0[3]); w.z = cvt_pk_bf16(v1[0], v1[1]); w.w = cvt_pk_bf16(v1[2], v1[3]);
                        *(u32x4*)(rowp + bj * HALF) = w; } }
        }
    }
};
struct EpiY {
    static constexpr bool PERM = true, AFTER_DRAIN = false, MID = true, ABLK = true;
    typedef float f32x2v __attribute__((ext_vector_type(2)));
    bf16_t* Y; int ldc; float* ssq; const PG8_LAS f32x2v* tab;
    __device__ __forceinline__ void mid(f32x4 (&acc)[2][2][4][2], int ui, int wr, int fr) const {
#pragma unroll
        for (int ai = 0; ai < 2; ++ai)
#pragma unroll
            for (int m = 0; m < 4; ++m) { const float r = tab[ui * BM + ai * HALF + wr * 64 + m * 16 + fr].x;
#pragma unroll
                for (int bj = 0; bj < 2; ++bj)
#pragma unroll
                    for (int n = 0; n < 2; ++n) acc[ai][bj][m][n] = acc[ai][bj][m][n] * r; }
    }
    __device__ __forceinline__ void operator()(const f32x4 (&acc)[2][2][4][2], const Unit& u, int wr, int wc, int fr, int fq, int ui) const {
        const int row0 = u.pm * BM + wr * 64 + fr; const int col0 = u.pn * BM + wc * 32 + 8 * fq;
#pragma unroll
        for (int ai = 0; ai < 2; ++ai)
#pragma unroll
            for (int m = 0; m < 4; ++m) { const int row = row0 + ai * HALF + m * 16; const float f = tab[ui * BM + ai * HALF + wr * 64 + m * 16 + fr].y;
                bf16_t* rowp = Y + (size_t)row * ldc + col0; float s = 0.f;
#pragma unroll
                for (int bj = 0; bj < 2; ++bj) { const f32x4 v0 = acc[ai][bj][m][0] * f, v1 = acc[ai][bj][m][1] * f;
                    s += (v0[0] * v0[0] + v0[1] * v0[1]) + (v0[2] * v0[2] + v0[3] * v0[3]) + (v1[0] * v1[0] + v1[1] * v1[1]) + (v1[2] * v1[2] + v1[3] * v1[3]);
                    u32x4 w; w.x = cvt_pk_bf16(v0[0], v0[1]); w.y = cvt_pk_bf16(v0[2], v0[3]); w.z = cvt_pk_bf16(v1[0], v1[1]); w.w = cvt_pk_bf16(v1[2], v1[3]);
                    *(u32x4*)(rowp + bj * HALF) = w; }
                s += __shfl_xor(s, 16); s += __shfl_xor(s, 32);
                if (fq == 0) ssq[(size_t)row * 32 + u.pn * 4 + wc] = s; }
    }
};

template <class Epi, class Sched, bool ALIGN_EPI = false, bool SP2 = false>
__device__ __forceinline__ void gemm_phase(PG8_LAS unsigned char* lds, const Gemm g, const Sched& S, const Epi& E) {
    const int tid = threadIdx.x, wid = __builtin_amdgcn_readfirstlane(tid >> 6), lane = tid & 63, wr = wid >> 2, wc = wid & 3, fr = lane & 15, fq = lane >> 4;
    const int K = g.K, nt = K / BK;
    unsigned voffA[2], voffB[2];
#pragma unroll
    for (int i = 0; i < 2; ++i) { int R, C; stage_rc(tid * 16 + i * 8192, R, C); const int Rb = Epi::PERM ? ((R & ~31) + perm32(R & 31)) : R;
        voffA[i] = Epi::ABLK ? (unsigned)((((R >> 5) * (K >> 3) + (C >> 3)) * 256 + (R & 31) * 8) * 2) : (unsigned)(R * K + C) * 2u; voffB[i] = (unsigned)(Rb * K + C) * 2u; }
    const size_t kstep = (size_t)(BK * 2);
    const size_t kstepA = Epi::ABLK ? (size_t)(8 * 512) : kstep;
    const size_t hstep = (size_t)HALF * K * 2;
    const size_t tstep = 2 * hstep;
    const unsigned ldsw = (unsigned)wid * 1024u;
    const int aoff = lds_byte(wr * 64 + fr, fq * 8), boff = lds_byte(wc * 32 + fr, fq * 8);
#define PG8_SA(b, h) (((b) * 2 + (h)) * HTB)
#define PG8_SB(b, h) ((4 + (b) * 2 + (h)) * HTB)
#define PG8_STAGE(bufoff, gbase, voff) do { _Pragma("unroll") for (int _i = 0; _i < 2; ++_i) \
        __builtin_amdgcn_global_load_lds((const unsigned*)((const char*)(gbase) + (voff)[_i]), (PG8_LAS unsigned*)(lds + (bufoff) + ldsw + _i * 8192), 16, 0, 0); } while (0)
#define PG8_LDA(dst, b, h) do { _Pragma("unroll") for (int m = 0; m < 4; ++m) _Pragma("unroll") for (int k = 0; k < 2; ++k) dst[m][k] = *(const PG8_LAS bf16x8*)(lds + PG8_SA(b, h) + aoff + m * 2048 + k * 1024); } while (0)
#define PG8_LDB(dst, b, h) do { _Pragma("unroll") for (int n = 0; n < 2; ++n) _Pragma("unroll") for (int k = 0; k < 2; ++k) dst[n][k] = *(const PG8_LAS bf16x8*)(lds + PG8_SB(b, h) + boff + n * 2048 + k * 1024); } while (0)
#define PG8_MMA(ai, bj, At, Bt) do { __builtin_amdgcn_s_setprio(1); _Pragma("unroll") for (int m = 0; m < 4; ++m) _Pragma("unroll") for (int n = 0; n < 2; ++n) _Pragma("unroll") for (int k = 0; k < 2; ++k) \
        acc[ai][bj][m][n] = __builtin_amdgcn_mfma_f32_16x16x32_bf16(Bt[n][k], At[m][k], acc[ai][bj][m][n], 0, 0, 0); __builtin_amdgcn_s_setprio(0); } while (0)
#define PG8_WAIT_V(n) asm volatile("s_waitcnt vmcnt(" #n ")" ::: "memory")
#define PG8_WAIT_L(n) asm volatile("s_waitcnt lgkmcnt(" #n ")" ::: "memory")
#define PG8_BAR __builtin_amdgcn_s_barrier()
#define PG8_SCHED __builtin_amdgcn_sched_barrier(0)
    Unit cur, nxt; int ui = 0;
    if (!S.next(0, cur)) return;
    f32x4 acc[2][2][4][2];
#pragma unroll
    for (int a = 0; a < 2; ++a)
#pragma unroll
        for (int b = 0; b < 2; ++b)
#pragma unroll
            for (int m = 0; m < 4; ++m)
#pragma unroll
                for (int n = 0; n < 2; ++n) acc[a][b][m][n] = (f32x4){0.f, 0.f, 0.f, 0.f};
    bf16x8 At[4][2], B0[2][2], B1[2][2];
    const char* cA = (const char*)g.A + (size_t)cur.pm * tstep; const char* cB = (const char*)g.Bt + (size_t)cur.pn * tstep;
    S.a_ready(cur);
    if constexpr (SP2) {
        PG8_STAGE(PG8_SB(0, 0), cB, voffB); PG8_STAGE(PG8_SB(0, 1), cB + hstep, voffB); PG8_STAGE(PG8_SA(0, 0), cA, voffA); PG8_STAGE(PG8_SA(0, 1), cA + hstep, voffA);
        if (wr == 1) PG8_BAR;
        PG8_WAIT_V(2); PG8_BAR;
        PG8_STAGE(PG8_SB(1, 0), cB + kstep, voffB); PG8_STAGE(PG8_SA(1, 0), cA + kstepA, voffA); PG8_STAGE(PG8_SB(1, 1), cB + hstep + kstep, voffB);
        PG8_WAIT_V(6); PG8_BAR;
    } else {
        PG8_STAGE(PG8_SB(0, 0), cB, voffB); PG8_STAGE(PG8_SA(0, 0), cA, voffA); PG8_STAGE(PG8_SB(0, 1), cB + hstep, voffB); PG8_STAGE(PG8_SA(0, 1), cA + hstep, voffA);
        if (wr == 1) PG8_BAR;
        PG8_WAIT_V(4); PG8_BAR;
        PG8_STAGE(PG8_SB(1, 0), cB + kstep, voffB); PG8_STAGE(PG8_SA(1, 0), cA + kstepA, voffA); PG8_STAGE(PG8_SB(1, 1), cB + hstep + kstep, voffB);
        PG8_WAIT_V(6); PG8_BAR;
    }
    for (;;) {
        const bool has_next = S.next(ui + 1, nxt);
        const char* nA = has_next ? (const char*)g.A + (size_t)nxt.pm * tstep : cA; const char* nB = has_next ? (const char*)g.Bt + (size_t)nxt.pn * tstep : cB;
        for (int t = 0; t < nt; t += 2) {
            const bool last = (t == nt - 2);
            const char* a1 = cA + (size_t)(t + 1) * kstepA;
            const char* a2 = last ? nA : cA + (size_t)(t + 2) * kstepA; const char* b2 = last ? nB : cB + (size_t)(t + 2) * kstep;
            const char* a3 = a2 + kstepA; const char* b3 = b2 + kstep;
            if (last && has_next) S.a_ready(nxt);
            if constexpr (Epi::MID) { if (t == nt / 2) { E.mid(acc, ui, wr, fr); PG8_SCHED; } }
            if constexpr (SP2) {
            PG8_LDB(B0, 0, 0); PG8_LDB(B1, 0, 1); PG8_SCHED; PG8_LDA(At, 0, 0); PG8_STAGE(PG8_SA(1, 1), a1 + hstep, voffA);
            PG8_WAIT_V(8); PG8_WAIT_L(0); PG8_BAR; PG8_MMA(0, 0, At, B0); PG8_MMA(0, 1, At, B1); PG8_BAR; PG8_SCHED;
            PG8_LDA(At, 0, 1); PG8_STAGE(PG8_SB(0, 0), b2, voffB); PG8_STAGE(PG8_SB(0, 1), b2 + hstep, voffB); PG8_STAGE(PG8_SA(0, 0), a2, voffA);
            PG8_WAIT_V(8); PG8_WAIT_L(0); PG8_BAR; PG8_MMA(1, 0, At, B0); PG8_MMA(1, 1, At, B1); PG8_BAR; PG8_SCHED;
            PG8_LDB(B0, 1, 0); PG8_LDB(B1, 1, 1); PG8_SCHED; PG8_LDA(At, 1, 0); PG8_STAGE(PG8_SA(0, 1), a2 + hstep, voffA);
            PG8_WAIT_V(8); PG8_WAIT_L(0); PG8_BAR; PG8_MMA(0, 0, At, B0); PG8_MMA(0, 1, At, B1); PG8_BAR; PG8_SCHED;
            PG8_LDA(At, 1, 1); PG8_STAGE(PG8_SB(1, 0), b3, voffB); PG8_STAGE(PG8_SB(1, 1), b3 + hstep, voffB); PG8_STAGE(PG8_SA(1, 0), a3, voffA);
            PG8_WAIT_V(8); PG8_WAIT_L(0); PG8_BAR; PG8_MMA(1, 0, At, B0); PG8_MMA(1, 1, At, B1); PG8_BAR; PG8_SCHED;
            } else {
            PG8_LDB(B0, 0, 0); PG8_SCHED; PG8_LDA(At, 0, 0); PG8_STAGE(PG8_SA(1, 1), a1 + hstep, voffA);
            PG8_WAIT_L(8); PG8_BAR; PG8_WAIT_L(0); PG8_MMA(0, 0, At, B0); PG8_BAR; PG8_SCHED;
            PG8_LDB(B1, 0, 1); PG8_STAGE(PG8_SB(0, 0), b2, voffB);
            PG8_BAR; PG8_WAIT_L(0); PG8_MMA(0, 1, At, B1); PG8_BAR;
            PG8_LDA(At, 0, 1); PG8_STAGE(PG8_SA(0, 0), a2, voffA);
            PG8_BAR; PG8_WAIT_L(0); PG8_MMA(1, 0, At, B0); PG8_BAR; PG8_SCHED;
            PG8_STAGE(PG8_SB(0, 1), b2 + hstep, voffB);
            PG8_WAIT_V(6); PG8_BAR; PG8_MMA(1, 1, At, B1); PG8_BAR;
            PG8_LDB(B0, 1, 0); PG8_SCHED; PG8_LDA(At, 1, 0); PG8_STAGE(PG8_SA(0, 1), a2 + hstep, voffA);
            PG8_WAIT_L(8); PG8_BAR; PG8_WAIT_L(0); PG8_MMA(0, 0, At, B0); PG8_BAR; PG8_SCHED;
            PG8_LDB(B1, 1, 1); PG8_STAGE(PG8_SB(1, 0), b3, voffB);
            PG8_BAR; PG8_WAIT_L(0); PG8_MMA(0, 1, At, B1); PG8_BAR;
            PG8_LDA(At, 1, 1); PG8_STAGE(PG8_SA(1, 0), a3, voffA);
            PG8_BAR; PG8_WAIT_L(0); PG8_MMA(1, 0, At, B0); PG8_BAR; PG8_SCHED;
            PG8_STAGE(PG8_SB(1, 1), b3 + hstep, voffB);
            PG8_WAIT_V(6); PG8_BAR; PG8_MMA(1, 1, At, B1); PG8_BAR;
            }
        }
        if constexpr (ALIGN_EPI) { if (wr == 0) PG8_BAR; }
        if constexpr (!Epi::AFTER_DRAIN) { E(acc, cur, wr, wc, fr, fq, ui); S.done(cur); }
        if (!has_next) break;
#pragma unroll
        for (int a = 0; a < 2; ++a)
#pragma unroll
            for (int b = 0; b < 2; ++b)
#pragma unroll
                for (int m = 0; m < 4; ++m)
#pragma unroll
                    for (int n = 0; n < 2; ++n) acc[a][b][m][n] = (f32x4){0.f, 0.f, 0.f, 0.f};
        cur = nxt; cA = nA; cB = nB; ++ui;
        if constexpr (ALIGN_EPI) { if (wr == 1) PG8_BAR; }
    }
    PG8_WAIT_V(0);
    if constexpr (!ALIGN_EPI) { if (wr == 0) PG8_BAR; }
    PG8_BAR;
#undef PG8_SA
#undef PG8_SB
#undef PG8_STAGE
#undef PG8_LDA
#undef PG8_LDB
#undef PG8_MMA
#undef PG8_WAIT_V
#undef PG8_WAIT_L
#undef PG8_BAR
#undef PG8_SCHED
}
}

constexpr int NWAVES = 8;
constexpr int N_LAUNCHES = MK_N_LAUNCHES;
constexpr int PER_PHASE = 5;
constexpr int M = 16384, DM = 2048, NP = 6656, HD = 64;
constexpr int NKV = 2560;
constexpr int KV_KSB = 0, KV_VSB = 1024, KV_KSW = 2048, KV_VSW = 2304;
__host__ __device__ __forceinline__ int cperm(int p) { return 16 * ((p >> 3) & 3) + 8 * ((p >> 2) & 1) + 4 * (p >> 5) + (p & 3); }
__host__ __device__ __forceinline__ size_t b32_off(int row, int col) { return ((size_t)(row >> 5) * 256 + (col >> 3)) * 256 + (row & 31) * 8 + (col & 7); }
constexpr float RMS_EPS = 1e-6f;
constexpr float LOG2E = 1.4426950408889634f;
constexpr float QSCALE = 0.125f * LOG2E;

constexpr size_t MiB = 1u << 20;
constexpr size_t WS_CTL = 0, CTL_ZERO_BYTES = 1 * MiB;
constexpr size_t WS_WIN = 2 * MiB;
constexpr size_t WS_WOUT = 28 * MiB;
constexpr size_t WS_SSQ1 = 36 * MiB;
constexpr size_t WS_SSQ2 = 38 * MiB;
constexpr size_t WS_XN = 40 * MiB;
constexpr size_t WS_Y = WS_XN;
constexpr size_t WS_A2 = 104 * MiB;
constexpr size_t WS_KV = 168 * MiB;
constexpr size_t WS_QB = 248 * MiB;
constexpr size_t WS_ZB = 312 * MiB;
constexpr size_t WS_END = 376 * MiB;
constexpr int CW_TMO = 0, CW_CODE = 1;
constexpr int CW_BAR = 4096;

constexpr int RING_OFF = 0, RING_BYTES = 131072;
constexpr int LDSCTL_OFF = RING_BYTES, MISC_OFF = LDSCTL_OFF + 320;
constexpr int TAB_OFF = RING_BYTES + 1024;
constexpr int LDS_BYTES = 147456;
static_assert(TAB_OFF + 4096 <= LDS_BYTES && MISC_OFF + 128 <= TAB_OFF, "LDS map");

#define GAS __attribute__((address_space(1)))
#define LAS __attribute__((address_space(3)))
typedef unsigned short bf16;
typedef unsigned v4u __attribute__((ext_vector_type(4)));
typedef unsigned v2u __attribute__((ext_vector_type(2)));
typedef float f32x4 __attribute__((ext_vector_type(4)));
typedef float f32x2 __attribute__((ext_vector_type(2)));
typedef float f32x16 __attribute__((ext_vector_type(16)));
typedef short bf16x8 __attribute__((ext_vector_type(8)));
typedef short s16x4 __attribute__((ext_vector_type(4)));
typedef GAS unsigned gu32;
#define RLX_AGENT __ATOMIC_RELAXED, __HIP_MEMORY_SCOPE_AGENT
#define LDS_WAIT() asm volatile("s_waitcnt lgkmcnt(0)" ::: "memory")
#define VM_WAIT() asm volatile("s_waitcnt vmcnt(0)" ::: "memory")
__device__ __forceinline__ unsigned f2bf(float f) { unsigned u = __builtin_bit_cast(unsigned, f); return (u + 0x7fffu + ((u >> 16) & 1u)) >> 16; }
__device__ __forceinline__ unsigned pk2(float lo, float hi) { return f2bf(lo) | (f2bf(hi) << 16); }
__device__ __forceinline__ float bf_lo(unsigned w) { return __builtin_bit_cast(float, w << 16); }
__device__ __forceinline__ float bf_hi(unsigned w) { return __builtin_bit_cast(float, w & 0xffff0000u); }

#define XB_TMO      128
#define XB_XCNT(j)  (256  + 64 * (j))
#define XB_XSUB(j)  (1280 + 64 * (j))
#define XB_XGEN(j)  (2304 + 64 * (j))
#define XB_TOP      3328
#define XB_TOPGEN   3392
#define XCD_BAR_WORDS 3456
#define XB_SPIN_CAP (1u << 18)
__device__ __forceinline__ unsigned xb_ld(unsigned* p)              { return __hip_atomic_load(p, __ATOMIC_RELAXED, __HIP_MEMORY_SCOPE_AGENT); }
__device__ __forceinline__ unsigned xb_add(unsigned* p, unsigned v) { return __hip_atomic_fetch_add(p, v, __ATOMIC_RELAXED, __HIP_MEMORY_SCOPE_AGENT); }
__device__ __forceinline__ unsigned xb_xcc_id() { return (unsigned)__builtin_amdgcn_s_getreg((3 << 11) | 20) & 0xFu; }
#define XB_SPIN(cond, bar) do { unsigned _sp = 0; while (cond) { __builtin_amdgcn_s_sleep(1); \
    if ((++_sp & 255u) == 0u) { if (xb_ld(&(bar)[XB_TMO])) break; if (_sp > XB_SPIN_CAP) { atomicAdd(&(bar)[XB_TMO], 1u); break; } } } } while (0)
struct XcdBarrier { unsigned* bar; unsigned x; volatile LAS unsigned* st; };
__device__ __forceinline__ XcdBarrier xcd_barrier_post(unsigned* bar, volatile LAS unsigned* st) {
    XcdBarrier b; b.bar = bar; b.x = xb_xcc_id(); b.st = st;
    if (threadIdx.x == 0) (void)xb_add(&bar[XB_XCNT(b.x)], 1u);
    return b;
}
__device__ __forceinline__ void xcd_barrier_complete(unsigned* bar, unsigned x, unsigned& nloc, unsigned& nx) {
    const unsigned G = gridDim.x * gridDim.y * gridDim.z;
    unsigned sum, cnt, mine, sp = 0u;
    for (;;) {
        sum = 0u; cnt = 0u; mine = 0u;
#pragma unroll
        for (unsigned j = 0; j < 16; ++j) { const unsigned c = xb_ld(&bar[XB_XCNT(j)]); sum += c; cnt += (c > 0u) ? 1u : 0u; mine = (j == x) ? c : mine; }
        if (sum == G) break;
        __builtin_amdgcn_s_sleep(1);
        if ((++sp & 255u) == 0u) { if (xb_ld(&bar[XB_TMO])) break; if (sp > XB_SPIN_CAP) { atomicAdd(&bar[XB_TMO], 1u); break; } }
    }
    nloc = mine > 0u ? mine : 1u; nx = cnt > 0u ? cnt : 1u;
}
__device__ __forceinline__ void xcd_barrier(const XcdBarrier& b) {
    asm volatile("s_waitcnt vmcnt(0)" ::: "memory");
    __syncthreads();
    if (threadIdx.x == 0) {
        unsigned* bar = b.bar;
        __builtin_amdgcn_s_waitcnt(0);
        unsigned nloc = b.st[0], nx = b.st[1];
        if (nloc == 0u) { xcd_barrier_complete(bar, b.x, nloc, nx); b.st[0] = nloc; b.st[1] = nx; }
        const unsigned old = xb_add(&bar[XB_XSUB(b.x)], 1u);
        const unsigned gen = old / nloc;
        if (old + 1u == (gen + 1u) * nloc) {
            __builtin_amdgcn_fence(__ATOMIC_RELEASE, "agent");
            asm volatile("s_waitcnt vmcnt(0)" ::: "memory");
            const unsigned og = xb_add(&bar[XB_TOP], 1u);
            const unsigned tg = og / nx;
            if (og + 1u == (tg + 1u) * nx) xb_add(&bar[XB_TOPGEN], 1u);
            else XB_SPIN(xb_ld(&bar[XB_TOPGEN]) == tg, bar);
            __builtin_amdgcn_fence(__ATOMIC_ACQUIRE, "agent");
            xb_add(&bar[XB_XGEN(b.x)], 1u);
            asm volatile("s_waitcnt vmcnt(0)" ::: "memory");
        } else {
            XB_SPIN(xb_ld(&bar[XB_XGEN(b.x)]) == gen, bar);
            __builtin_amdgcn_fence(__ATOMIC_ACQUIRE, "agent");
            asm volatile("s_waitcnt vmcnt(0)" ::: "memory");
        }
    }
    __syncthreads();
}

struct Frame {
    LAS unsigned char* lds;
    volatile LAS unsigned* MISC;
    gu32* ctl;
    int tid, lane, wave;
    int vcu, G;
    const float *x, *w_in, *w_out, *g_pre, *g_post, *gn_sb, *gn_sw, *sinks, *rel_bias; float* out;
    bf16 *WinT, *WoutT, *XN, *A2, *KV, *QB, *ZB, *Y; float *SSQ1, *SSQ2;
};

__device__ __forceinline__ float wave_sum(float v) {
#pragma unroll
    for (int o = 1; o < 64; o <<= 1) v += __shfl_xor(v, o);
    return v;
}
template <int MODE>
__device__ __forceinline__ void p0_transpose_item(const float* W, int K, int N, bf16* WT, LAS float* scr, int item, int lane, const float* gsb, const float* gsw) {
    const int nblk = N / 32, kb = item / nblk, nb = item % nblk, k0 = 64 * kb, n0 = 32 * nb;
    int ncol = n0 + (lane & 31);
    if (MODE == 1) { const bool gate = (n0 >= 3072 && n0 < 4096) || n0 >= 5632; if (gate) ncol = (ncol & ~63) + cperm(ncol & 63); }
#pragma unroll 8
    for (int i = 0; i < 32; ++i) { const int kk = 2 * i + (lane >> 5); int krow = k0 + kk; float gmul = 1.f;
        if (MODE == 2) { krow = k0 + cperm(kk); gmul = krow < 1024 ? gsb[krow] : gsw[krow - 1024]; }
        scr[kk * 33 + (lane & 31)] = W[(size_t)krow * N + ncol] * gmul; }
    LDS_WAIT(); asm volatile("" ::: "memory");
    const int c = lane & 7;
#pragma unroll
    for (int j = 0; j < 4; ++j) { const int n = (lane >> 3) + 8 * j; const LAS float* sp = scr + (8 * c) * 33 + n;
        v4u o; o.x = pk2(sp[0 * 33], sp[1 * 33]); o.y = pk2(sp[2 * 33], sp[3 * 33]); o.z = pk2(sp[4 * 33], sp[5 * 33]); o.w = pk2(sp[6 * 33], sp[7 * 33]);
        *(GAS v4u*)(WT + (size_t)(n0 + n) * K + k0 + 8 * c) = o; }
    LDS_WAIT(); asm volatile("" ::: "memory");
}
__device__ __forceinline__ void rms_row_to_bf16(int lane, const float* xrow, const float* g, bf16* orow) {
    const GAS f32x4* xr = (const GAS f32x4*)xrow + lane; const GAS f32x4* gr = (const GAS f32x4*)g + lane;
    f32x4 v[8]; float s = 0.f;
#pragma unroll
    for (int j = 0; j < 8; ++j) { v[j] = xr[64 * j]; s += (v[j].x * v[j].x + v[j].y * v[j].y) + (v[j].z * v[j].z + v[j].w * v[j].w); }
    const float rstd = 1.f / sqrtf(wave_sum(s) * (1.f / DM) + RMS_EPS);
    GAS v2u* o8 = (GAS v2u*)orow + lane;
#pragma unroll
    for (int j = 0; j < 8; ++j) { const f32x4 gg = gr[64 * j]; v2u o; o.x = pk2(v[j].x * rstd * gg.x, v[j].y * rstd * gg.y); o.y = pk2(v[j].z * rstd * gg.z, v[j].w * rstd * gg.w); o8[64 * j] = o; }
}
__device__ __forceinline__ void p0_prologue(Frame& F) {
    LAS float* scr = (LAS float*)(F.lds + RING_OFF + F.wave * 16384);
    const int gw = F.vcu * NWAVES + F.wave, NGW = F.G * NWAVES;
    constexpr int I_IN = (DM / 64) * (NP / 32), I_OUT = (DM / 64) * (DM / 32);
    for (int it = gw; it < I_IN + I_OUT; it += NGW) {
        if (it < I_IN) p0_transpose_item<1>(F.w_in, DM, NP, F.WinT, scr, it, F.lane, nullptr, nullptr);
        else p0_transpose_item<2>(F.w_out, DM, DM, F.WoutT, scr, it - I_IN, F.lane, F.gn_sb, F.gn_sw);
    }
    for (int m = gw; m < M; m += NGW) rms_row_to_bf16(F.lane, F.x + (size_t)m * DM, F.g_pre, F.XN + (size_t)m * DM);
}
__device__ __forceinline__ void p4_final(Frame& F) {
    const int gw = F.vcu * NWAVES + F.wave, NGW = F.G * NWAVES;
    for (int m = gw; m < M; m += NGW) {
        float s = (F.lane < 32) ? *(const GAS float*)(F.SSQ2 + (size_t)m * 32 + F.lane) : 0.f;
        const float rs = 1.f / sqrtf(wave_sum(s) * (1.f / DM) + RMS_EPS);
        const GAS f32x4* xr = (const GAS f32x4*)(F.x + (size_t)m * DM) + F.lane; const GAS f32x4* gr = (const GAS f32x4*)F.g_post + F.lane;
        const GAS v2u* yr = (const GAS v2u*)(F.Y + (size_t)m * DM) + F.lane; GAS f32x4* orow = (GAS f32x4*)(F.out + (size_t)m * DM) + F.lane;
#pragma unroll
        for (int j = 0; j < 8; ++j) { const f32x4 xv = xr[64 * j], gg = gr[64 * j]; const v2u yv = yr[64 * j];
            f32x4 o; o.x = xv.x + bf_lo(yv.x) * rs * gg.x; o.y = xv.y + bf_hi(yv.x) * rs * gg.y; o.z = xv.z + bf_lo(yv.y) * rs * gg.z; o.w = xv.w + bf_hi(yv.y) * rs * gg.w;
            orow[64 * j] = o; }
    }
}

namespace att {
constexpr int NSLOT = 16, KB = 4096;
constexpr int DEPTH = 4;
#define ATT_N_EARLY 21
#define ATT_N_LATE 8
static_assert(2 * DEPTH + 13 == ATT_N_EARLY && 2 * DEPTH == ATT_N_LATE, "wait counts");
constexpr int L_K = 0, L_V = NSLOT * KB;
constexpr int X_TBL = RING_BYTES + 1024, X_FLG = RING_BYTES + 2048, X_TRASH = RING_BYTES + 4096;
static_assert(L_V + NSLOT * KB <= RING_BYTES && X_TRASH + 8 * 1024 <= LDS_BYTES, "attention LDS map");
__device__ __forceinline__ int crow(int r, int hi) { return (r & 3) + 8 * (r >> 2) + 4 * hi; }
__device__ __forceinline__ float swap_lo(float v, float& hi_out) {
    auto rr = __builtin_amdgcn_permlane32_swap(__float_as_uint(v), __float_as_uint(v), false, false);
    hi_out = __uint_as_float(rr[1]); return __uint_as_float(rr[0]);
}
__device__ __forceinline__ float min_s(float a, float b) { return __builtin_amdgcn_fmed3f(a, -INFINITY, b); }
typedef short v4i16_t __attribute__((ext_vector_type(4)));
__device__ __forceinline__ s16x4 vtr(const LAS unsigned char* p) { return __builtin_bit_cast(s16x4, __builtin_amdgcn_ds_read_tr16_b64_v4i16((LAS v4i16_t*)p)); }
__device__ __forceinline__ void glds16(const void* gsrc, unsigned lds_dst) { unsigned keep;
    asm volatile("s_mov_b32 %0, m0\n\ts_mov_b32 m0, %2\n\ts_nop 0\n\tglobal_load_lds_dwordx4 %1, off\n\ts_mov_b32 m0, %0" : "=&s"(keep) : "v"(gsrc), "s"(lds_dst) : "memory"); }
__device__ __forceinline__ void dma(const Frame& F, const bf16* dsrc, int tile) {
    const int t = tile < 0 ? 0 : tile;
    const unsigned off = tile < 0 ? (unsigned)(X_TRASH + F.wave * 1024) : (unsigned)(RING_OFF + (F.wave >> 2) * L_V + (tile & (NSLOT - 1)) * KB + (F.wave & 3) * 1024);
    glds16(dsrc + (size_t)t * 32 * NKV, (unsigned)__builtin_amdgcn_readfirstlane((unsigned)(uintptr_t)F.lds + off));
}
#define ATT_STEPBAR_(N) asm volatile("s_waitcnt vmcnt(" #N ") lgkmcnt(0)\n\ts_barrier" ::: "memory")
#define ATT_STEPBAR(N) ATT_STEPBAR_(N)
__device__ __forceinline__ void ld_q(bf16x8 (&q)[4], const bf16* p) {
    asm volatile("global_load_dwordx4 %0, %4, off\n\tglobal_load_dwordx4 %1, %4, off offset:1024\n\tglobal_load_dwordx4 %2, %4, off offset:2048\n\tglobal_load_dwordx4 %3, %4, off offset:3072"
                 : "=&v"(q[0]), "=&v"(q[1]), "=&v"(q[2]), "=&v"(q[3]) : "v"(p) : "memory"); }
__device__ __forceinline__ void ld_z(v4u (&z)[4], const bf16* p) {
    asm volatile("global_load_dwordx4 %0, %4, off\n\tglobal_load_dwordx4 %1, %4, off offset:512\n\tglobal_load_dwordx4 %2, %4, off offset:1024\n\tglobal_load_dwordx4 %3, %4, off offset:1536"
                 : "=&v"(z[0]), "=&v"(z[1]), "=&v"(z[2]), "=&v"(z[3]) : "v"(p) : "memory"); }
#define ATT_PIN(q, z) asm volatile("" : "+v"(q[0]), "+v"(q[1]), "+v"(q[2]), "+v"(q[3]), "+v"(z[0]), "+v"(z[1]), "+v"(z[2]), "+v"(z[3]))

template <bool SB>
__device__ __forceinline__ void stream(Frame& F, const int head, const int chunk) {
    const int lane = F.lane, wid = F.wave, r32 = lane & 31, hh = lane >> 5;
    __builtin_amdgcn_s_waitcnt(0);
    LAS unsigned char* ring = F.lds + RING_OFF;
    volatile LAS unsigned char* flg = (volatile LAS unsigned char*)(F.lds + X_FLG);
    LAS float* tbl = (LAS float*)(F.lds + X_TBL);
    const int kcol = SB ? KV_KSB + head * HD : KV_KSW + (head >> 2) * HD;
    const int vcol = SB ? KV_VSB + head * HD : KV_VSW + (head >> 2) * HD;
    const bf16* dsrc;
    { const int row = 8 * (wid & 3) + (lane >> 3), cp = lane & 7;
      const int ch = (wid < 4) ? (cp ^ ((row >> 1) & 7)) : (cp ^ (((row >> 1) & 1) << 2));
      dsrc = F.KV + (size_t)row * NKV + ((wid < 4) ? kcol : vcol) + ch * 8; }
    if (!SB) {
        if (F.tid < 192) { const int dist = 159 - F.tid; float v = -INFINITY;
            if (dist >= 0 && dist < 128) { int b = dist; if (dist >= 16) { b = 16 + (int)(logf((float)dist * (1.f / 16.f)) / 2.0794415416798357f * 16.f); b = b > 31 ? 31 : b; }
                v = F.rel_bias[b * 16 + head] * LOG2E; }
            tbl[F.tid] = v; }
    }
    const float sink2 = SB ? 0.f : F.sinks[head] * LOG2E;
    int koff[4];
#pragma unroll
    for (int d0 = 0; d0 < 4; ++d0) koff[d0] = r32 * 128 + (((2 * d0 + hh) ^ ((r32 >> 1) & 7)) << 4);
    const int vq = (lane & 15) >> 2, vxb = (vq >> 1) & 1, vcl = 2 * ((lane >> 4) & 1) + ((lane & 3) >> 1);
    const int voff0 = (4 * hh + vq) * 128 + ((4 * vxb + vcl) << 4) + (lane & 1) * 8, voff1 = (4 * hh + vq) * 128 + ((4 * (1 - vxb) + vcl) << 4) + (lane & 1) * 8;
    const size_t lrow = (size_t)wid * 256 * 256 + r32 * 8, hpiece = (size_t)((SB ? 0 : 128) + head * 8) * 256;
    const bf16* qbase = F.QB + lrow + hpiece + hh * 256;
    const bf16* zbase = F.ZB + lrow + hpiece + hh * 4 * 256;
    bf16* abase = F.A2 + lrow + hpiece + hh * 4 * 256;
    float* sbase = F.SSQ1 + (size_t)((SB ? 0 : 16) + head) * M + wid * 32 + r32;
    const int qt_hi = 4 * chunk + 3;
    int nextload = 8 * qt_hi + 7;
    int jprev = 0, gs = 0;
    bf16x8 qn[4]; v4u zn[4];
    for (int qi = 0; qi < 4; ++qi) {
        const int qt = qt_hi - qi, T0 = 8 * qt, q0 = qt * 256;
        if (qi == 0 || nextload >= T0 || nextload < T0 - 9 || jprev < DEPTH) {
            VM_WAIT();
            if (nextload < T0 - 9) nextload = T0 + 7;
            if (qi == 0) { ld_q(qn, qbase + (size_t)q0 * 2048); ld_z(zn, zbase + (size_t)q0 * 2048); }
            const int lo = T0 - 8 < 0 ? 0 : T0 - 8;
            for (int t = nextload; t >= lo; --t) dma(F, dsrc, t);
            if (nextload >= lo) nextload = lo - 1;
            ATT_STEPBAR(0);
            ATT_PIN(qn, zn);
        }
        bf16x8 qr[4]; v4u zz[4];
#pragma unroll
        for (int d0 = 0; d0 < 4; ++d0) { qr[d0] = qn[d0]; zz[d0] = zn[d0]; }
        { const int qnx = (qi < 3 ? q0 - 256 : q0);
          ld_q(qn, qbase + (size_t)qnx * 2048); ld_z(zn, zbase + (size_t)qnx * 2048); }
        f32x16 o0 = {}, o1 = {};
        float carry = 1.f;
        float mrun = sink2, lrun = 1.f;
        bool done = false;
        int j = 0, extra = 0;
        for (;; ++j) {
            const int kt = T0 + wid - j;
            const bool act = (kt >= 0) && !done;
            { const int lim = T0 - j - 8;
              const int t0 = nextload >= lim ? nextload : -1; nextload -= (nextload >= lim);
              const int t1 = nextload >= lim ? nextload : -1; nextload -= (nextload >= lim);
              dma(F, dsrc, t0); dma(F, dsrc, t1); }
            if (act) {
              const f32x16 so0 = o0, so1 = o1; const float scarry = carry, smrun = mrun, slrun = lrun;
              for (int rep = 0; rep < MK_ATT_DUP; ++rep) {
                asm volatile("" ::: "memory");
                if (MK_ATT_DUP > 1) { o0 = so0; o1 = so1; carry = scarry; mrun = smrun; lrun = slrun; }
                const int slot = kt & (NSLOT - 1);
                const LAS unsigned char* kp = ring + L_K + slot * KB;
                const LAS unsigned char* vp = ring + L_V + slot * KB;
                f32x16 p;
                if (SB) p = (f32x16){};
                else { const LAS float* tb = tbl + (159 - 32 * j - r32 + 4 * hh);
#pragma unroll
                    for (int r = 0; r < 16; ++r) p[r] = tb[crow(r, 0)]; }
#pragma unroll
                for (int d0 = 0; d0 < 4; ++d0) { const bf16x8 kf = *(const LAS bf16x8*)(kp + koff[d0]); p = __builtin_amdgcn_mfma_f32_32x32x16_bf16(kf, qr[d0], p, 0, 0, 0); }
                float w[16];
                if (SB) {
                    float s[16];
#pragma unroll
                    for (int r = 0; r < 16; ++r) { s[r] = __builtin_amdgcn_rcpf(1.f + __builtin_amdgcn_exp2f(p[r])); }
                    if (j == 0) {
#pragma unroll
                        for (int r = 0; r < 16; ++r) { const bool msk = crow(r, hh) >= r32; s[r] = msk ? 1.f : s[r]; }
                    }
#pragma unroll
                    for (int r = 0; r < 16; ++r) w[r] = 1.f - s[r];
                    float r1[4], P4[4];
#pragma unroll
                    for (int g = 0; g < 4; ++g) { s[4 * g + 2] *= s[4 * g + 3]; s[4 * g + 1] *= s[4 * g + 2]; const float gt = s[4 * g] * s[4 * g + 1]; const float r0 = swap_lo(gt, r1[g]); P4[g] = r0 * r1[g]; }
                    float A[4]; A[3] = carry; A[2] = A[3] * P4[3]; A[1] = A[2] * P4[2]; A[0] = A[1] * P4[1]; carry = A[0] * P4[0];
#pragma unroll
                    for (int g = 0; g < 4; ++g) { const float off = hh == 0 ? A[g] * r1[g] : A[g];
                        w[4 * g + 3] *= off; w[4 * g + 2] *= s[4 * g + 3] * off; w[4 * g + 1] *= s[4 * g + 2] * off; w[4 * g] *= s[4 * g + 1] * off; }
                } else {
                    float rm = p[0];
#pragma unroll
                    for (int r = 1; r < 16; ++r) rm = fmaxf(rm, p[r]);
                    { float hi; const float lo = swap_lo(rm, hi); rm = fmaxf(lo, hi); }
                    const float mn = fmaxf(mrun, rm), alpha = __builtin_amdgcn_exp2f(mrun - mn); mrun = mn;
                    float sum = 0.f;
#pragma unroll
                    for (int r = 0; r < 16; ++r) { w[r] = __builtin_amdgcn_exp2f(p[r] - mn); sum += w[r]; }
                    { float hi; const float lo = swap_lo(sum, hi); sum = lo + hi; }
                    lrun = lrun * alpha + sum;
#pragma unroll
                    for (int r = 0; r < 16; ++r) { o0[r] *= alpha; o1[r] *= alpha; }
                }
#pragma unroll
                for (int s2 = 0; s2 < 2; ++s2) {
                    v4u wp; wp.x = pg8::cvt_pk_bf16(w[8 * s2 + 0], w[8 * s2 + 1]); wp.y = pg8::cvt_pk_bf16(w[8 * s2 + 2], w[8 * s2 + 3]); wp.z = pg8::cvt_pk_bf16(w[8 * s2 + 4], w[8 * s2 + 5]); wp.w = pg8::cvt_pk_bf16(w[8 * s2 + 6], w[8 * s2 + 7]);
                    const bf16x8 wf = __builtin_bit_cast(bf16x8, wp);
                    { const s16x4 lo = vtr(vp + voff0 + (16 * s2) * 128), hi = vtr(vp + voff0 + (16 * s2 + 8) * 128);
                      o0 = __builtin_amdgcn_mfma_f32_32x32x16_bf16((bf16x8){lo[0], lo[1], lo[2], lo[3], hi[0], hi[1], hi[2], hi[3]}, wf, o0, 0, 0, 0); }
                    { const s16x4 lo = vtr(vp + voff1 + (16 * s2) * 128), hi = vtr(vp + voff1 + (16 * s2 + 8) * 128);
                      o1 = __builtin_amdgcn_mfma_f32_32x32x16_bf16((bf16x8){lo[0], lo[1], lo[2], lo[3], hi[0], hi[1], hi[2], hi[3]}, wf, o1, 0, 0, 0); }
                }
              }
            }
            if (SB) done = done || (kt <= 0) || __all(carry == 0.f);
            else done = done || (kt <= 0) || (j >= 4);
            if (lane == 0) flg[(gs & 1) * 8 + wid] = done ? 1 : 0;
            if (j < DEPTH) ATT_STEPBAR(ATT_N_EARLY); else ATT_STEPBAR(ATT_N_LATE);
            const unsigned long long fl = *(volatile LAS unsigned long long*)(F.lds + X_FLG + (gs & 1) * 8);
            ++gs;
            if (fl == 0x0101010101010101ull) { if (MK_ATT_EXTRA == 0 || extra >= MK_ATT_EXTRA) break; ++extra; }
        }
        jprev = j;
        if (!SB) { const float il = 1.f / lrun;
#pragma unroll
            for (int r = 0; r < 16; ++r) { o0[r] *= il; o1[r] *= il; } }
        { float ss = 0.f;
#pragma unroll
          for (int r = 0; r < 16; ++r) ss += o0[r] * o0[r] + o1[r] * o1[r];
          float hi; const float lo = swap_lo(ss, hi); ss = lo + hi;
          sbase[q0] = ss; }
        for (int rep = 0; rep < MK_ATT_DUPST; ++rep)
#pragma unroll
        for (int m = 0; m < 4; ++m) {
            float a[8];
#pragma unroll
            for (int e = 0; e < 4; ++e) { a[e] = (m < 2) ? o0[8 * m + e] : o1[8 * (m - 2) + e]; a[4 + e] = (m < 2) ? o0[8 * m + 4 + e] : o1[8 * (m - 2) + 4 + e]; }
            a[0] *= bf_lo(zz[m].x); a[1] *= bf_hi(zz[m].x); a[2] *= bf_lo(zz[m].y); a[3] *= bf_hi(zz[m].y);
            a[4] *= bf_lo(zz[m].z); a[5] *= bf_hi(zz[m].z); a[6] *= bf_lo(zz[m].w); a[7] *= bf_hi(zz[m].w);
            v4u ow; ow.x = pg8::cvt_pk_bf16(a[0], a[1]); ow.y = pg8::cvt_pk_bf16(a[2], a[3]); ow.z = pg8::cvt_pk_bf16(a[4], a[5]); ow.w = pg8::cvt_pk_bf16(a[6], a[7]);
            *(GAS v4u*)(abase + (size_t)q0 * 2048 + m * 256) = ow;
        }
        if (j < DEPTH) VM_WAIT();
        ATT_PIN(qn, zn);
    }
    VM_WAIT();
}

__device__ __forceinline__ void phase(Frame& F) {
    for (int v = F.vcu; v < 256; v += F.G) {
        stream<true>(F, v >> 4, v & 15);
        __syncthreads();
        stream<false>(F, v >> 4, v & 15);
        __syncthreads();
    }
}
}

struct Args { const float* in[9]; float* out; unsigned char* ws; int ph_lo, ph_hi, li, pad; };
__global__ void __launch_bounds__(NWAVES * 64, 2) hymba_fwd(Args args) {
    extern __shared__ __attribute__((aligned(16))) unsigned char lds[];
    Frame F;
    F.lds = (LAS unsigned char*)lds;
    F.MISC = (volatile LAS unsigned*)(F.lds + MISC_OFF);
    F.tid = threadIdx.x; F.lane = F.tid & 63; F.wave = __builtin_amdgcn_readfirstlane(F.tid >> 6);
    F.G = gridDim.x; { const int bx = blockIdx.x; F.vcu = (F.G % 8 == 0) ? (bx % 8) * (F.G / 8) + bx / 8 : bx; }
    unsigned char* ws = args.ws;
    F.ctl = (gu32*)(ws + WS_CTL);
    F.x = args.in[0]; F.w_in = args.in[1]; F.w_out = args.in[2]; F.g_pre = args.in[3]; F.g_post = args.in[4]; F.gn_sb = args.in[5]; F.gn_sw = args.in[6]; F.sinks = args.in[7]; F.rel_bias = args.in[8];
    F.out = args.out;
    F.WinT = (bf16*)(ws + WS_WIN); F.WoutT = (bf16*)(ws + WS_WOUT); F.XN = (bf16*)(ws + WS_XN); F.A2 = (bf16*)(ws + WS_A2); F.KV = (bf16*)(ws + WS_KV); F.QB = (bf16*)(ws + WS_QB); F.ZB = (bf16*)(ws + WS_ZB); F.Y = (bf16*)(ws + WS_Y);
    F.SSQ1 = (float*)(ws + WS_SSQ1); F.SSQ2 = (float*)(ws + WS_SSQ2);
    for (int u = F.tid; u < (TAB_OFF - LDSCTL_OFF) / 4; u += NWAVES * 64) ((LAS unsigned*)(F.lds + LDSCTL_OFF))[u] = 0u;
    __syncthreads();
    XcdBarrier bar; bar.bar = (unsigned*)(F.ctl + CW_BAR); bar.x = 0; bar.st = nullptr;
    if (N_LAUNCHES != PER_PHASE) bar = xcd_barrier_post((unsigned*)(F.ctl + CW_BAR), F.MISC + 8);
#define GRID_BAR(seam) do { if (N_LAUNCHES == PER_PHASE) { if (F.tid == 0) __hip_atomic_store(F.ctl + CW_TMO, 0xBADBA0u | (unsigned)(seam), RLX_AGENT); } else { xcd_barrier(bar); } } while (0)
    const int lo = args.ph_lo, hi = args.ph_hi;
#define IN(k) (lo <= (k) && (k) < hi)
#define BOTH(k) (IN(k) && IN((k) + 1))

    if (IN(0)) { p0_prologue(F); if (MK_REPEAT == 0) p0_prologue(F); if (BOTH(0)) GRID_BAR(0); }

    if (IN(1)) {
        pg8::Gemm g{F.XN, F.WinT, M, NP, DM}; pg8::StaticOrder S; S.init(M, NP, F.G, (int)blockIdx.x);
        pg8::EpiProj E{F.KV, F.QB, F.ZB, QSCALE};
        pg8::gemm_phase<pg8::EpiProj, pg8::StaticOrder, true, true>(F.lds + RING_OFF, g, S, E);
        if (MK_REPEAT == 1) pg8::gemm_phase<pg8::EpiProj, pg8::StaticOrder, true, true>(F.lds + RING_OFF, g, S, E);
        if (BOTH(1)) GRID_BAR(1);
    }

    if (IN(2)) { att::phase(F); if (MK_REPEAT == 2) att::phase(F); if (BOTH(2)) GRID_BAR(2); }

    if (IN(3)) {
        pg8::StaticOrder S; S.init(M, DM, F.G, (int)blockIdx.x);
        LAS f32x2* tab = (LAS f32x2*)(F.lds + TAB_OFF);
        { const int ui = F.tid >> 8, row = F.tid & 255; pg8::Unit u;
          if (S.next(ui, u)) { const GAS float* sp = (const GAS float*)(F.SSQ1 + (size_t)(u.pm * 256 + row));
              float a = 0.f, b = 0.f;
#pragma unroll
              for (int i = 0; i < 16; ++i) { a += sp[(size_t)i * M]; b += sp[(size_t)(16 + i) * M]; }
              const float rsb = 1.f / sqrtf(a * (1.f / 1024.f) + RMS_EPS), rsw = 1.f / sqrtf(b * (1.f / 1024.f) + RMS_EPS);
              tab[ui * 256 + row] = (f32x2){rsb / rsw, rsw}; } }
        __syncthreads();
        pg8::Gemm g{F.A2, F.WoutT, M, DM, DM};
        pg8::EpiY E{F.Y, DM, F.SSQ2, (const LAS pg8::EpiY::f32x2v*)tab};
        pg8::gemm_phase<pg8::EpiY, pg8::StaticOrder, true, true>(F.lds + RING_OFF, g, S, E);
        if (MK_REPEAT == 3) pg8::gemm_phase<pg8::EpiY, pg8::StaticOrder, true, true>(F.lds + RING_OFF, g, S, E);
        if (BOTH(3)) GRID_BAR(3);
    }

    if (IN(4)) { p4_final(F); if (MK_REPEAT == 4) p4_final(F); }
#undef IN
#undef BOTH
}

extern "C" void kernel_launch(void* const* d_in, const int* in_sizes, int n_in, void* d_out, int out_size, void* d_ws, size_t ws_size, hipStream_t stream) {
    static int grid = 0;
    if (grid == 0) {
        if (n_in != 9 || in_sizes[0] != M * DM || out_size != M * DM || ws_size < WS_END) { fprintf(stderr, "kernel_launch: unexpected shapes (n_in %d, in0 %d, out %d, ws %zu); nothing launched\n", n_in, n_in > 0 ? in_sizes[0] : -1, out_size, ws_size); grid = -1; return; }
        int dev = 0, cus = 0, per_cu = 0;
        if (hipGetDevice(&dev) != hipSuccess || hipDeviceGetAttribute(&cus, hipDeviceAttributeMultiprocessorCount, dev) != hipSuccess) { fprintf(stderr, "kernel_launch: device query failed\n"); grid = -1; return; }
        if (hipFuncSetAttribute((const void*)hymba_fwd, hipFuncAttributeMaxDynamicSharedMemorySize, LDS_BYTES) != hipSuccess) { fprintf(stderr, "kernel_launch: hipFuncSetAttribute failed\n"); grid = -1; return; }
        if (hipOccupancyMaxActiveBlocksPerMultiprocessor(&per_cu, (const void*)hymba_fwd, NWAVES * 64, LDS_BYTES) != hipSuccess || per_cu < 1) { fprintf(stderr, "kernel_launch: occupancy query reports %d workgroups per CU\n", per_cu); per_cu = 1; }
        (void)hipGetLastError();
        grid = cus;
    }
    if (grid < 0) return;
    if (hipMemsetAsync((char*)d_ws + WS_CTL, 0, CTL_ZERO_BYTES, stream) != hipSuccess) { fprintf(stderr, "kernel_launch: hipMemsetAsync failed\n"); return; }
    Args a{};
    for (int i = 0; i < 9; ++i) a.in[i] = (const float*)d_in[i];
    a.out = (float*)d_out; a.ws = (unsigned char*)d_ws;
    for (int li = 0; li < N_LAUNCHES; ++li) {
        a.ph_lo = (N_LAUNCHES == PER_PHASE) ? li : 0; a.ph_hi = (N_LAUNCHES == PER_PHASE) ? li + 1 : PER_PHASE; a.li = li;
        hipLaunchKernelGGL(hymba_fwd, dim3(grid), dim3(NWAVES * 64), LDS_BYTES, stream, a);
        const hipError_t le = hipPeekAtLastError();
        if (le != hipSuccess) { fprintf(stderr, "kernel_launch: launch %d failed: %s\n", li, hipGetErrorName(le)); break; }
    }
}
```
